# Optimizing an MI355X kernel written in HIP

```python
import jax, jax.numpy as jnp
from jax import lax
import numpy as np

D_MODEL = 1024
BATCH = 8
SEQ = 2048
DEPTH = 1
DEC_BATCH = 128
DEC_SEQ = 4
PAST_LEN = 16384
PAGE_SIZE = 128

D_MIX = D_MODEL
D_RWKV = D_MIX // 2
D_CONV = D_MIX - D_RWKV
HEAD_SIZE = 64
N_HEADS_RWKV = D_RWKV // HEAD_SIZE
LORA_W = 64
LORA_A = 64
LORA_G = 128
CONV_W = 3
D_FF = 2816
ALPHA = (2.0 * DEPTH) ** 0.25
BETA = (8.0 * DEPTH) ** -0.25
LN_EPS = 1e-5
GN_EPS = 1e-5 * HEAD_SIZE

OFF_R = 0
OFF_K = OFF_R + D_RWKV
OFF_V = OFF_K + D_RWKV
OFF_WD = OFF_V + D_RWKV
OFF_AD = OFF_WD + LORA_W
OFF_GD = OFF_AD + LORA_A
P_SHIFT = OFF_GD + LORA_G
OFF_CB = P_SHIFT
OFF_CC = OFF_CB + D_CONV
OFF_CH = OFF_CC + D_CONV
P_TOTAL = OFF_CH + D_CONV

kernel_name = "hymba_rwkv7_shortconv_macaron_deepnorm_step"


def layer_norm(x, g, b):
    xf = x.astype(jnp.float32)
    mu = jnp.mean(xf, axis=-1, keepdims=True)
    var = jnp.mean(jnp.square(xf - mu), axis=-1, keepdims=True)
    return ((xf - mu) * lax.rsqrt(var + LN_EPS) * g.astype(jnp.float32) + b.astype(jnp.float32)).astype(x.dtype)


def swiglu(x, wg, wu, wd):
    return (jax.nn.silu(x @ wg) * (x @ wu)) @ wd


def wkv7_recurrence(r, w, k, v, kk, a, s0):
    def step(s, inp):
        r_t, w_t, k_t, v_t, kk_t, a_t = inp
        sa = jnp.einsum("bhij,bhj->bhi", s, -kk_t)
        s = (s * w_t[:, :, None, :]
             + sa[..., None] * (kk_t * a_t)[:, :, None, :]
             + v_t[..., None] * k_t[:, :, None, :])
        o_t = jnp.einsum("bhij,bhj->bhi", s, r_t)
        return s, o_t
    xs = (jnp.moveaxis(r, 1, 0), jnp.moveaxis(w, 1, 0), jnp.moveaxis(k, 1, 0),
          jnp.moveaxis(v, 1, 0), jnp.moveaxis(kk, 1, 0), jnp.moveaxis(a, 1, 0))
    s_final, o = lax.scan(step, s0, xs)
    return jnp.moveaxis(o, 0, 1), s_final


def trunk_layer(x, wkv0, shift0, conv0, p):
    f32 = jnp.float32
    bsz, T, _ = x.shape
    x = layer_norm(ALPHA * x + 0.5 * swiglu(x, p["ffn1_wg"], p["ffn1_wu"], p["ffn1_wd"]), p["ln1_g"], p["ln1_b"])

    proj = x @ p["w_in"]

    ps = proj[..., :P_SHIFT]
    prev = jnp.concatenate([shift0[:, None, :].astype(ps.dtype), ps[:, :-1]], axis=1)
    ps_mix = ps + p["mu_shift"] * (prev - ps)
    new_shift = ps[:, -1]
    r = ps_mix[..., OFF_R:OFF_K]
    k = ps_mix[..., OFF_K:OFF_V]
    v = ps_mix[..., OFF_V:OFF_WD]
    wd = ps_mix[..., OFF_WD:OFF_AD]
    ad = ps_mix[..., OFF_AD:OFF_GD]
    gd = ps_mix[..., OFF_GD:P_SHIFT]

    w_log = -jax.nn.softplus(-(p["w0"] + jnp.tanh(wd) @ p["w_lora_up"]).astype(f32)) - 0.5
    decay = jnp.exp(-jnp.exp(w_log))
    a = jax.nn.sigmoid((p["a0"] + ad @ p["a_lora_up"]).astype(f32))
    g = jax.nn.sigmoid(gd) @ p["g_lora_up"]

    def heads(t):
        return t.astype(f32).reshape(bsz, T, N_HEADS_RWKV, HEAD_SIZE)

    def headvec(t):
        return t.astype(f32).reshape(N_HEADS_RWKV, HEAD_SIZE)

    r_h, k_h, v_h, a_h, w_h = heads(r), heads(k), heads(v), heads(a), heads(decay)
    kk = k_h * headvec(p["k_k"])
    kk = kk / jnp.maximum(jnp.sqrt(jnp.sum(kk * kk, axis=-1, keepdims=True)), 1e-12)
    k_h = k_h * (1.0 + (a_h - 1.0) * headvec(p["k_a"]))

    o, wkv_new = wkv7_recurrence(r_h, w_h, k_h, v_h, kk, a_h, wkv0.astype(f32))
    o_mu = jnp.mean(o, axis=-1, keepdims=True)
    o_var = jnp.mean(jnp.square(o - o_mu), axis=-1, keepdims=True)
    o = (o - o_mu) * lax.rsqrt(o_var + GN_EPS) * headvec(p["lnx_g"]) + headvec(p["lnx_b"])
    o = o + jnp.sum(r_h * k_h * p["r_k"].astype(f32), axis=-1, keepdims=True) * v_h
    y_rwkv = o.reshape(bsz, T, D_RWKV).astype(x.dtype) * g

    c_b = proj[..., OFF_CB:OFF_CC]
    c_c = proj[..., OFF_CC:OFF_CH]
    c_h = proj[..., OFF_CH:P_TOTAL]
    u = c_c * c_h
    u_full = jnp.concatenate([conv0.astype(u.dtype), u], axis=1)
    cw = p["conv_w"]
    z = cw[0] * u_full[:, 0:T]
    for i in range(1, CONV_W):
        z = z + cw[i] * u_full[:, i:i + T]
    new_conv = u_full[:, T:]
    y_conv = c_b * z

    mix = jnp.concatenate([y_rwkv, y_conv], axis=-1) @ p["w_out"]
    x = layer_norm(ALPHA * x + mix, p["ln2_g"], p["ln2_b"])
    x = layer_norm(ALPHA * x + 0.5 * swiglu(x, p["ffn2_wg"], p["ffn2_wu"], p["ffn2_wd"]), p["ln3_g"], p["ln3_b"])
    return x, wkv_new, new_shift, new_conv


def setup_inputs(seed: int = 0) -> dict:
    key = jax.random.key(seed)
    ks = iter(jax.random.split(key, 40))

    def nrm(shape, scale):
        return jax.random.normal(next(ks), shape, jnp.float32) * scale

    d = D_MODEL
    col_scale = jnp.ones((P_TOTAL,), jnp.float32).at[OFF_V:OFF_WD].set(BETA)
    inp = {}
    inp["x_prompt"] = nrm((BATCH, SEQ, d), 1.0)
    inp["x_sample"] = nrm((DEC_BATCH, DEC_SEQ, d), 1.0)
    inp["state_wkv"] = nrm((DEPTH, DEC_BATCH, N_HEADS_RWKV, HEAD_SIZE, HEAD_SIZE), 0.5)
    inp["state_shift"] = nrm((DEPTH, DEC_BATCH, P_SHIFT), 1.0)
    inp["state_conv"] = nrm((DEPTH, DEC_BATCH, CONV_W - 1, D_CONV), 1.0)
    inp["ln1_g"] = 1.0 + nrm((DEPTH, d), 0.05)
    inp["ln1_b"] = nrm((DEPTH, d), 0.02)
    inp["ffn1_wg"] = nrm((DEPTH, d, D_FF), d ** -0.5)
    inp["ffn1_wu"] = nrm((DEPTH, d, D_FF), d ** -0.5)
    inp["ffn1_wd"] = nrm((DEPTH, D_FF, d), BETA * D_FF ** -0.5)
    inp["w_in"] = nrm((DEPTH, d, P_TOTAL), d ** -0.5) * col_scale
    inp["mu_shift"] = jax.random.uniform(next(ks), (DEPTH, P_SHIFT), jnp.float32)
    inp["w0"] = -3.0 + nrm((DEPTH, D_RWKV), 1.0)
    inp["w_lora_up"] = nrm((DEPTH, LORA_W, D_RWKV), 0.5 * LORA_W ** -0.5)
    inp["a0"] = nrm((DEPTH, D_RWKV), 0.3)
    inp["a_lora_up"] = nrm((DEPTH, LORA_A, D_RWKV), 0.5 * LORA_A ** -0.5)
    inp["g_lora_up"] = nrm((DEPTH, LORA_G, D_RWKV), LORA_G ** -0.5)
    inp["k_k"] = 0.85 + nrm((DEPTH, D_RWKV), 0.05)
    inp["k_a"] = 1.0 + nrm((DEPTH, D_RWKV), 0.05)
    inp["r_k"] = nrm((DEPTH, N_HEADS_RWKV, HEAD_SIZE), 0.1)
    inp["lnx_g"] = 1.0 + nrm((DEPTH, D_RWKV), 0.05)
    inp["lnx_b"] = nrm((DEPTH, D_RWKV), 0.02)
    inp["conv_w"] = nrm((DEPTH, CONV_W, D_CONV), CONV_W ** -0.5)
    inp["w_out"] = nrm((DEPTH, D_MIX, d), BETA * D_MIX ** -0.5)
    inp["ln2_g"] = 1.0 + nrm((DEPTH, d), 0.05)
    inp["ln2_b"] = nrm((DEPTH, d), 0.02)
    inp["ffn2_wg"] = nrm((DEPTH, d, D_FF), d ** -0.5)
    inp["ffn2_wu"] = nrm((DEPTH, d, D_FF), d ** -0.5)
    inp["ffn2_wd"] = nrm((DEPTH, D_FF, d), BETA * D_FF ** -0.5)
    inp["ln3_g"] = 1.0 + nrm((DEPTH, d), 0.05)
    inp["ln3_b"] = nrm((DEPTH, d), 0.02)
    return inp


def reference(x_prompt, x_sample, state_wkv, state_shift, state_conv,
              ln1_g, ln1_b, ffn1_wg, ffn1_wu, ffn1_wd, w_in, mu_shift, w0, w_lora_up,
              a0, a_lora_up, g_lora_up, k_k, k_a, r_k, lnx_g, lnx_b, conv_w, w_out,
              ln2_g, ln2_b, ffn2_wg, ffn2_wu, ffn2_wd, ln3_g, ln3_b):
    xp = x_prompt
    xs = x_sample
    bp = x_prompt.shape[0]
    wkv_p, shift_p, conv_p = [], [], []
    wkv_s, shift_s, conv_s = [], [], []
    for l in range(DEPTH):
        p = {
            "ln1_g": ln1_g[l], "ln1_b": ln1_b[l],
            "ffn1_wg": ffn1_wg[l], "ffn1_wu": ffn1_wu[l], "ffn1_wd": ffn1_wd[l],
            "w_in": w_in[l], "mu_shift": mu_shift[l], "w0": w0[l], "w_lora_up": w_lora_up[l],
            "a0": a0[l], "a_lora_up": a_lora_up[l], "g_lora_up": g_lora_up[l],
            "k_k": k_k[l], "k_a": k_a[l], "r_k": r_k[l], "lnx_g": lnx_g[l], "lnx_b": lnx_b[l],
            "conv_w": conv_w[l], "w_out": w_out[l],
            "ln2_g": ln2_g[l], "ln2_b": ln2_b[l],
            "ffn2_wg": ffn2_wg[l], "ffn2_wu": ffn2_wu[l], "ffn2_wd": ffn2_wd[l],
            "ln3_g": ln3_g[l], "ln3_b": ln3_b[l],
        }
        wkv0_p = jnp.zeros((bp, N_HEADS_RWKV, HEAD_SIZE, HEAD_SIZE), jnp.float32)
        shift0_p = jnp.zeros((bp, P_SHIFT), xp.dtype)
        conv0_p = jnp.zeros((bp, CONV_W - 1, D_CONV), xp.dtype)
        xp, wp, sp, cp = trunk_layer(xp, wkv0_p, shift0_p, conv0_p, p)
        xs, wsm, ssm, csm = trunk_layer(xs, state_wkv[l], state_shift[l], state_conv[l], p)
        wkv_p.append(wp); shift_p.append(sp); conv_p.append(cp)
        wkv_s.append(wsm); shift_s.append(ssm); conv_s.append(csm)
    return (xp, xs,
            jnp.stack(wkv_p), jnp.stack(shift_p), jnp.stack(conv_p),
            jnp.stack(wkv_s), jnp.stack(shift_s), jnp.stack(conv_s))
```

```cpp
#include <hip/hip_runtime.h>
#include <cstdio>
#include <cstdint>
namespace pg8 {
#define PG8_LAS __attribute__((address_space(3)))
typedef unsigned short bf16_t;
typedef short bf16x8 __attribute__((ext_vector_type(8)));
typedef float f32x4 __attribute__((ext_vector_type(4)));
typedef unsigned u32x4 __attribute__((ext_vector_type(4)));
constexpr int BM = 256, BK = 64, HALF = 128, HTB = HALF * BK * 2  , STAGE_BYTES = 8 * HTB, NXCD = 8, WGM = 8;

__host__ __device__ __forceinline__ int lds_byte(int r, int c) { const int st = (r >> 4) * 2 + (c >> 5), rr = r & 15, cc = c & 31, ob = rr * 64 + cc * 2; return st * 1024 + (ob ^ (((ob >> 9) & 1) << 5)); }
__host__ __device__ __forceinline__ void stage_rc(int b, int& R, int& C) { const int st = b / 1024, sb = b % 1024, swz = sb ^ (((sb >> 9) & 1) << 5); R = (st >> 1) * 16 + swz / 64; C = (st & 1) * 32 + (swz % 64) / 2; }
__host__ __device__ __forceinline__ int perm32(int rho) { const int n = rho >> 4, i = rho & 15; return 8 * (i >> 2) + 4 * n + (i & 3); }

struct Unit { int pm, pn; };
struct Gemm { const bf16_t* A; const bf16_t* Bt; int M, N, K; };

struct StaticOrder {
    int nM, nN, nwg, G, c;
    __host__ __device__ void init(int M, int N, int G_, int c_) { nM = M / BM; nN = N / BM; nwg = nM * nN; G = G_; c = c_; }
    __host__ __device__ bool next(int i, Unit& u) const {
        const long L = (long)i * G + c; if (L >= nwg) return false;
        int wgid = (int)L; { const int q = nwg / NXCD, r = nwg % NXCD, xcd = wgid % NXCD, off = wgid / NXCD; wgid = (xcd < r ? xcd * (q + 1) : r * (q + 1) + (xcd - r) * q) + off; }
        const int nig = WGM * nN, gid = wgid / nig, fm = gid * WGM, gsz = (nM - fm) < WGM ? (nM - fm) : WGM;
        u.pm = fm + ((wgid % nig) % gsz); u.pn = (wgid % nig) / gsz; return true;
    }
    __device__ __forceinline__ void a_ready(const Unit&) const {}
    __device__ __forceinline__ void done(const Unit&) const {}
};

__device__ __forceinline__ unsigned cvt_pk_bf16(float lo, float hi) { unsigned r; asm volatile("v_cvt_pk_bf16_f32 %0, %1, %2" : "=v"(r) : "v"(lo), "v"(hi)); return r; }
typedef float f32x2 __attribute__((ext_vector_type(2)));
__device__ __forceinline__ f32x2 gelu_pk(f32x2 v) {
    const f32x2 av = __builtin_elementwise_abs(v), d = av * 0.2316418882f + 1.0f;
    f32x2 t; t.x = __builtin_amdgcn_rcpf(d.x); t.y = __builtin_amdgcn_rcpf(d.y);
    f32x2 q = t * 0.5307027145f + (-0.7265760135f); q = q * t + 0.7107068705f; q = q * t + (-0.142248368f); q = q * t + 0.127414796f; q = q * t;
    const f32x2 s = (v * v) * (-0.72134752044f);
    f32x2 e; e.x = __builtin_amdgcn_exp2f(s.x); e.y = __builtin_amdgcn_exp2f(s.y);
    const f32x2 m = v * (q * e), r = v - m;
    f32x2 o; o.x = v.x < 0.f ? m.x : r.x; o.y = v.y < 0.f ? m.y : r.y; return o;
}

template <int ACT  > struct EpiBf16 {
    static constexpr bool PERM = true, AFTER_DRAIN = false; static_assert(ACT == 0 || ACT == 1, "EpiBf16: ACT is 0 (none) or 1 (gelu_pk)");
    bf16_t* O; int ldc; const float* bias; int split_cols; size_t split_stride; float scale0;
    __device__ __forceinline__ void operator()(const f32x4 (&acc)[2][2][4][2], const Unit& u, int wr, int wc, int fr, int fq) const {
        const int row0 = u.pm * BM + wr * 64 + fr; int colt = u.pn * BM; bf16_t* base = O;
        float sc = 1.f; if (split_cols) { const int t = colt / split_cols; base += (size_t)t * split_stride; colt -= t * split_cols; if (t == 0) sc = scale0; }
        const int col0 = colt + wc * 32 + 8 * fq, bcol0 = u.pn * BM + wc * 32 + 8 * fq;
        f32x4 bv[2][2];
#pragma unroll
        for (int bj = 0; bj < 2; ++bj)
#pragma unroll
            for (int n = 0; n < 2; ++n) bv[bj][n] = bias ? *(const f32x4*)(bias + bcol0 + bj * HALF + 4 * n) : (f32x4){0.f, 0.f, 0.f, 0.f};
#pragma unroll
        for (int ai = 0; ai < 2; ++ai)
#pragma unroll
            for (int m = 0; m < 4; ++m) { bf16_t* rowp = base + (size_t)(row0 + ai * HALF + m * 16) * ldc + col0;
#pragma unroll
                for (int bj = 0; bj < 2; ++bj) { f32x4 v0 = acc[ai][bj][m][0] + bv[bj][0], v1 = acc[ai][bj][m][1] + bv[bj][1];
                    if (ACT == 1) { f32x2 a = gelu_pk((f32x2){v0[0], v0[1]}), b = gelu_pk((f32x2){v0[2], v0[3]}), c = gelu_pk((f32x2){v1[0], v1[1]}), d = gelu_pk((f32x2){v1[2], v1[3]});
                        v0 = (f32x4){a.x, a.y, b.x, b.y}; v1 = (f32x4){c.x, c.y, d.x, d.y}; }
                    v0 = v0 * sc; v1 = v1 * sc; u32x4 w; w.x = cvt_pk_bf16(v0[0], v0[1]); w.y = cvt_pk_bf16(v0[2], v0[3]); w.z = cvt_pk_bf16(v1[0], v1[1]); w.w = cvt_pk_bf16(v1[2], v1[3]);
                    *(u32x4*)(rowp + bj * HALF) = w; } }
    }
};
template <class Epi, class Sched, bool ALIGN_EPI = false, bool SP2 = false>
__device__ __forceinline__ void gemm_phase(PG8_LAS unsigned char* lds, const Gemm g, const Sched& S, const Epi& E) {
    const int tid = threadIdx.x, wid = __builtin_amdgcn_readfirstlane(tid >> 6), lane = tid & 63, wr = wid >> 2, wc = wid & 3, fr = lane & 15, fq = lane >> 4;
    const int K = g.K, nt = K / BK;
    unsigned voffA[2], voffB[2];
#pragma unroll
    for (int i = 0; i < 2; ++i) { int R, C; stage_rc(tid * 16 + i * 8192, R, C); const int Rb = Epi::PERM ? ((R & ~31) + perm32(R & 31)) : R;
        voffA[i] = (unsigned)(R * K + C) * 2u; voffB[i] = (unsigned)(Rb * K + C) * 2u; }
    const size_t kstep = (size_t)(BK * 2);
    const size_t hstep = (size_t)HALF * K * 2;
    const size_t tstep = 2 * hstep;
    const unsigned ldsw = (unsigned)wid * 1024u;
    const int aoff = lds_byte(wr * 64 + fr, fq * 8), boff = lds_byte(wc * 32 + fr, fq * 8);
#define PG8_SA(b, h) (((b) * 2 + (h)) * HTB)
#define PG8_SB(b, h) ((4 + (b) * 2 + (h)) * HTB)
#define PG8_STAGE(bufoff, gbase, voff) do { _Pragma("unroll") for (int _i = 0; _i < 2; ++_i) \
        __builtin_amdgcn_global_load_lds((const unsigned*)((const char*)(gbase) + (voff)[_i]), (PG8_LAS unsigned*)(lds + (bufoff) + ldsw + _i * 8192), 16, 0, 0); } while (0)
#define PG8_LDA(dst, b, h) do { _Pragma("unroll") for (int m = 0; m < 4; ++m) _Pragma("unroll") for (int k = 0; k < 2; ++k) dst[m][k] = *(const PG8_LAS bf16x8*)(lds + PG8_SA(b, h) + aoff + m * 2048 + k * 1024); } while (0)
#define PG8_LDB(dst, b, h) do { _Pragma("unroll") for (int n = 0; n < 2; ++n) _Pragma("unroll") for (int k = 0; k < 2; ++k) dst[n][k] = *(const PG8_LAS bf16x8*)(lds + PG8_SB(b, h) + boff + n * 2048 + k * 1024); } while (0)
#define PG8_MMA(ai, bj, At, Bt) do { __builtin_amdgcn_s_setprio(1); _Pragma("unroll") for (int m = 0; m < 4; ++m) _Pragma("unroll") for (int n = 0; n < 2; ++n) _Pragma("unroll") for (int k = 0; k < 2; ++k) \
        acc[ai][bj][m][n] = __builtin_amdgcn_mfma_f32_16x16x32_bf16(Bt[n][k], At[m][k], acc[ai][bj][m][n], 0, 0, 0); __builtin_amdgcn_s_setprio(0); } while (0)
#define PG8_WAIT_V(n) asm volatile("s_waitcnt vmcnt(" #n ")" ::: "memory")
#define PG8_WAIT_L(n) asm volatile("s_waitcnt lgkmcnt(" #n ")" ::: "memory")
#define PG8_BAR __builtin_amdgcn_s_barrier()
#define PG8_SCHED __builtin_amdgcn_sched_barrier(0)
    Unit cur, nxt; int ui = 0;
    if (!S.next(0, cur)) return;
    f32x4 acc[2][2][4][2];
#pragma unroll
    for (int a = 0; a < 2; ++a)
#pragma unroll
        for (int b = 0; b < 2; ++b)
#pragma unroll
            for (int m = 0; m < 4; ++m)
#pragma unroll
                for (int n = 0; n < 2; ++n) acc[a][b][m][n] = (f32x4){0.f, 0.f, 0.f, 0.f};
    bf16x8 At[4][2], B0[2][2], B1[2][2];
    const char* cA = (const char*)g.A + (size_t)cur.pm * tstep; const char* cB = (const char*)g.Bt + (size_t)cur.pn * tstep;
    S.a_ready(cur);
    if constexpr (SP2) {
        PG8_STAGE(PG8_SB(0, 0), cB, voffB); PG8_STAGE(PG8_SB(0, 1), cB + hstep, voffB); PG8_STAGE(PG8_SA(0, 0), cA, voffA); PG8_STAGE(PG8_SA(0, 1), cA + hstep, voffA);
        if (wr == 1) PG8_BAR;
        PG8_WAIT_V(2); PG8_BAR;
        PG8_STAGE(PG8_SB(1, 0), cB + kstep, voffB); PG8_STAGE(PG8_SA(1, 0), cA + kstep, voffA); PG8_STAGE(PG8_SB(1, 1), cB + hstep + kstep, voffB);
        PG8_WAIT_V(6); PG8_BAR;
    } else {
        PG8_STAGE(PG8_SB(0, 0), cB, voffB); PG8_STAGE(PG8_SA(0, 0), cA, voffA); PG8_STAGE(PG8_SB(0, 1), cB + hstep, voffB); PG8_STAGE(PG8_SA(0, 1), cA + hstep, voffA);
        if (wr == 1) PG8_BAR;
        PG8_WAIT_V(4); PG8_BAR;
        PG8_STAGE(PG8_SB(1, 0), cB + kstep, voffB); PG8_STAGE(PG8_SA(1, 0), cA + kstep, voffA); PG8_STAGE(PG8_SB(1, 1), cB + hstep + kstep, voffB);
        PG8_WAIT_V(6); PG8_BAR;
    }
    for (;;) {
        const bool has_next = S.next(ui + 1, nxt);
        const char* nA = has_next ? (const char*)g.A + (size_t)nxt.pm * tstep : cA; const char* nB = has_next ? (const char*)g.Bt + (size_t)nxt.pn * tstep : cB;
        for (int t = 0; t < nt; t += 2) {
            const bool last = (t == nt - 2);
            const char* a1 = cA + (size_t)(t + 1) * kstep;
            const char* a2 = last ? nA : cA + (size_t)(t + 2) * kstep; const char* b2 = last ? nB : cB + (size_t)(t + 2) * kstep;
            const char* a3 = a2 + kstep; const char* b3 = b2 + kstep;
            if (last && has_next) S.a_ready(nxt);
            if constexpr (SP2) {
            PG8_LDB(B0, 0, 0); PG8_LDB(B1, 0, 1); PG8_SCHED; PG8_LDA(At, 0, 0); PG8_STAGE(PG8_SA(1, 1), a1 + hstep, voffA);
            PG8_WAIT_V(8); PG8_WAIT_L(0); PG8_BAR; PG8_MMA(0, 0, At, B0); PG8_MMA(0, 1, At, B1); PG8_BAR; PG8_SCHED;
            PG8_LDA(At, 0, 1); PG8_STAGE(PG8_SB(0, 0), b2, voffB); PG8_STAGE(PG8_SB(0, 1), b2 + hstep, voffB); PG8_STAGE(PG8_SA(0, 0), a2, voffA);
            PG8_WAIT_V(8); PG8_WAIT_L(0); PG8_BAR; PG8_MMA(1, 0, At, B0); PG8_MMA(1, 1, At, B1); PG8_BAR; PG8_SCHED;
            PG8_LDB(B0, 1, 0); PG8_LDB(B1, 1, 1); PG8_SCHED; PG8_LDA(At, 1, 0); PG8_STAGE(PG8_SA(0, 1), a2 + hstep, voffA);
            PG8_WAIT_V(8); PG8_WAIT_L(0); PG8_BAR; PG8_MMA(0, 0, At, B0); PG8_MMA(0, 1, At, B1); PG8_BAR; PG8_SCHED;
            PG8_LDA(At, 1, 1); PG8_STAGE(PG8_SB(1, 0), b3, voffB); PG8_STAGE(PG8_SB(1, 1), b3 + hstep, voffB); PG8_STAGE(PG8_SA(1, 0), a3, voffA);
            PG8_WAIT_V(8); PG8_WAIT_L(0); PG8_BAR; PG8_MMA(1, 0, At, B0); PG8_MMA(1, 1, At, B1); PG8_BAR; PG8_SCHED;
            } else {
            PG8_LDB(B0, 0, 0); PG8_SCHED; PG8_LDA(At, 0, 0); PG8_STAGE(PG8_SA(1, 1), a1 + hstep, voffA);
            PG8_WAIT_L(8); PG8_BAR; PG8_WAIT_L(0); PG8_MMA(0, 0, At, B0); PG8_BAR; PG8_SCHED;
            PG8_LDB(B1, 0, 1); PG8_STAGE(PG8_SB(0, 0), b2, voffB);
            PG8_BAR; PG8_WAIT_L(0); PG8_MMA(0, 1, At, B1); PG8_BAR;
            PG8_LDA(At, 0, 1); PG8_STAGE(PG8_SA(0, 0), a2, voffA);
            PG8_BAR; PG8_WAIT_L(0); PG8_MMA(1, 0, At, B0); PG8_BAR; PG8_SCHED;
            PG8_STAGE(PG8_SB(0, 1), b2 + hstep, voffB);
            PG8_WAIT_V(6); PG8_BAR; PG8_MMA(1, 1, At, B1); PG8_BAR;
            PG8_LDB(B0, 1, 0); PG8_SCHED; PG8_LDA(At, 1, 0); PG8_STAGE(PG8_SA(0, 1), a2 + hstep, voffA);
            PG8_WAIT_L(8); PG8_BAR; PG8_WAIT_L(0); PG8_MMA(0, 0, At, B0); PG8_BAR; PG8_SCHED;
            PG8_LDB(B1, 1, 1); PG8_STAGE(PG8_SB(1, 0), b3, voffB);
            PG8_BAR; PG8_WAIT_L(0); PG8_MMA(0, 1, At, B1); PG8_BAR;
            PG8_LDA(At, 1, 1); PG8_STAGE(PG8_SA(1, 0), a3, voffA);
            PG8_BAR; PG8_WAIT_L(0); PG8_MMA(1, 0, At, B0); PG8_BAR; PG8_SCHED;
            PG8_STAGE(PG8_SB(1, 1), b3 + hstep, voffB);
            PG8_WAIT_V(6); PG8_BAR; PG8_MMA(1, 1, At, B1); PG8_BAR;
            }
        }
        if constexpr (ALIGN_EPI) { if (wr == 0) PG8_BAR; }
        if constexpr (!Epi::AFTER_DRAIN) { E(acc, cur, wr, wc, fr, fq); S.done(cur); }
        if (!has_next) break;
#pragma unroll
        for (int a = 0; a < 2; ++a)
#pragma unroll
            for (int b = 0; b < 2; ++b)
#pragma unroll
                for (int m = 0; m < 4; ++m)
#pragma unroll
                    for (int n = 0; n < 2; ++n) acc[a][b][m][n] = (f32x4){0.f, 0.f, 0.f, 0.f};
        cur = nxt; cA = nA; cB = nB; ++ui;
        if constexpr (ALIGN_EPI) { if (wr == 1) PG8_BAR; }
    }
    PG8_WAIT_V(0);
    if constexpr (!ALIGN_EPI) { if (wr == 0) PG8_BAR; }
    PG8_BAR;
    if constexpr (Epi::AFTER_DRAIN) { E.fused(acc, cur, wr, wc, fr, fq, lds, wid, lane); S.done(cur); }
#undef PG8_SA
#undef PG8_SB
#undef PG8_STAGE
#undef PG8_LDA
#undef PG8_LDB
#undef PG8_MMA
#undef PG8_WAIT_V
#undef PG8_WAIT_L
#undef PG8_BAR
#undef PG8_SCHED
}
}
#define GAS __attribute__((address_space(1)))
#define LAS __attribute__((address_space(3)))
typedef unsigned short bf16;
typedef unsigned v4u __attribute__((ext_vector_type(4)));
typedef float f32x4 __attribute__((ext_vector_type(4)));
typedef short bf16x8 __attribute__((ext_vector_type(8)));
typedef GAS unsigned gu32;
typedef GAS unsigned long long gu64;
#define RLX_AGENT __ATOMIC_RELAXED, __HIP_MEMORY_SCOPE_AGENT
#define LDS_WAIT() asm volatile("s_waitcnt lgkmcnt(0)" ::: "memory")
#define VM_WAIT() asm volatile("s_waitcnt vmcnt(0)" ::: "memory")
__device__ __forceinline__ unsigned long long rt() { return __builtin_amdgcn_s_memrealtime(); }
__device__ __forceinline__ unsigned f2bf(float f) { unsigned u = __builtin_bit_cast(unsigned, f); return (u + 0x7fffu + ((u >> 16) & 1u)) >> 16; }
__device__ __forceinline__ unsigned pk2(float lo, float hi) { return f2bf(lo) | (f2bf(hi) << 16); }

#define XB_TMO      128
#define XB_XCNT(j)  (256  + 64 * (j))
#define XB_XSUB(j)  (1280 + 64 * (j))
#define XB_XGEN(j)  (2304 + 64 * (j))
#define XB_TOP      3328
#define XB_TOPGEN   3392
#define XCD_BAR_WORDS 3456
#define XB_SPIN_CAP (1u << 18)

__device__ __forceinline__ unsigned xb_ld(unsigned* p)              { return __hip_atomic_load(p, __ATOMIC_RELAXED, __HIP_MEMORY_SCOPE_AGENT); }
__device__ __forceinline__ unsigned xb_add(unsigned* p, unsigned v) { return __hip_atomic_fetch_add(p, v, __ATOMIC_RELAXED, __HIP_MEMORY_SCOPE_AGENT); }
__device__ __forceinline__ unsigned xb_xcc_id() { return (unsigned)__builtin_amdgcn_s_getreg((3 << 11) | 20) & 0xFu; }
#define XB_SPIN(cond, bar) do { unsigned _sp = 0; while (cond) { __builtin_amdgcn_s_sleep(1); \
    if ((++_sp & 255u) == 0u) { if (xb_ld(&(bar)[XB_TMO])) break; if (_sp > XB_SPIN_CAP) { atomicAdd(&(bar)[XB_TMO], 1u); break; } } } } while (0)

struct XcdBarrier {
    unsigned* bar; unsigned x;
    volatile LAS unsigned* st;
};

__device__ __forceinline__ XcdBarrier xcd_barrier_post(unsigned* bar, volatile LAS unsigned* st) {
    XcdBarrier b; b.bar = bar; b.x = xb_xcc_id(); b.st = st;
    if (threadIdx.x == 0) (void)xb_add(&bar[XB_XCNT(b.x)], 1u);
    return b;
}
__device__ __forceinline__ void xcd_barrier_complete(unsigned* bar, unsigned x, unsigned& nloc, unsigned& nx) {
    const unsigned G = gridDim.x * gridDim.y * gridDim.z;
    unsigned sum, cnt, mine, sp = 0u;
    for (;;) {
        sum = 0u; cnt = 0u; mine = 0u;
#pragma unroll
        for (unsigned j = 0; j < 16; ++j) { const unsigned c = xb_ld(&bar[XB_XCNT(j)]); sum += c; cnt += (c > 0u) ? 1u : 0u; mine = (j == x) ? c : mine; }
        if (sum == G) break;
        __builtin_amdgcn_s_sleep(1);
        if ((++sp & 255u) == 0u) { if (xb_ld(&bar[XB_TMO])) break; if (sp > XB_SPIN_CAP) { atomicAdd(&bar[XB_TMO], 1u); break; } }
    }
    nloc = mine > 0u ? mine : 1u; nx = cnt > 0u ? cnt : 1u;
}

__device__ __forceinline__ void xcd_barrier(const XcdBarrier& b) {
    asm volatile("s_waitcnt vmcnt(0)" ::: "memory");
    __syncthreads();
    if (threadIdx.x == 0) {
        unsigned* bar = b.bar;
        __builtin_amdgcn_s_waitcnt(0);
        unsigned nloc = b.st[0], nx = b.st[1];
        if (nloc == 0u) { xcd_barrier_complete(bar, b.x, nloc, nx); b.st[0] = nloc; b.st[1] = nx; }
        const unsigned old = xb_add(&bar[XB_XSUB(b.x)], 1u);
        const unsigned gen = old / nloc;
        if (old + 1u == (gen + 1u) * nloc) {
            __builtin_amdgcn_fence(__ATOMIC_RELEASE, "agent");
            asm volatile("s_waitcnt vmcnt(0)" ::: "memory");
            const unsigned og = xb_add(&bar[XB_TOP], 1u);
            const unsigned tg = og / nx;
            if (og + 1u == (tg + 1u) * nx) xb_add(&bar[XB_TOPGEN], 1u);
            else XB_SPIN(xb_ld(&bar[XB_TOPGEN]) == tg, bar);
            __builtin_amdgcn_fence(__ATOMIC_ACQUIRE, "agent");
            xb_add(&bar[XB_XGEN(b.x)], 1u);
            asm volatile("s_waitcnt vmcnt(0)" ::: "memory");
        } else {
            XB_SPIN(xb_ld(&bar[XB_XGEN(b.x)]) == gen, bar);
            __builtin_amdgcn_fence(__ATOMIC_ACQUIRE, "agent");
            asm volatile("s_waitcnt vmcnt(0)" ::: "memory");
        }
    }
    __syncthreads();
}

constexpr int NWAVES = 8;
constexpr int D = 1024, FF = 2816, MP = 16384, MS = 512, M = MP + MS;
constexpr int PSH = 1792, PTOT = 3328, OFF_V = 1024, OFF_WD = 1536, OFF_CB = 1792, OFF_CC = 2304, OFF_CH = 2816;
constexpr int NH = 8, DR = 512;
constexpr int NGU = 2 * FF;
constexpr int NLORA = 1536, KLORA = 256;
constexpr float ALPHA = 1.189207115002721f;
constexpr float LN_EPS = 1e-5f, GN_EPS = 64e-5f;
constexpr size_t O_Y = 0, O_WKVP = (size_t)M * D, O_SHP = O_WKVP + 8 * 8 * 4096, O_CVP = O_SHP + 8 * PSH, O_WKVS = O_CVP + 8 * 2 * 512,
                 O_SHS = O_WKVS + (size_t)128 * 8 * 4096, O_CVS = O_SHS + 128 * PSH, O_END = O_CVS + 128 * 2 * 512;
constexpr size_t MiB = 1u << 20;
constexpr size_t WS_CTL = 0, CTL_ZERO_BYTES = 64 * 1024;
constexpr size_t WS_WGU1 = 1 * MiB, WS_WD1 = 12 * MiB, WS_WGU2 = 18 * MiB, WS_WD2 = 29 * MiB, WS_WIN = 35 * MiB, WS_WOUT = 42 * MiB, WS_WL = 44 * MiB;
constexpr size_t WS_XB = 45 * MiB;
constexpr size_t WS_BONUS = 78 * MiB;
constexpr size_t WS_H = 79 * MiB;
constexpr size_t WS_PROJ = 79 * MiB;
constexpr size_t WS_AP = 187 * MiB;
constexpr size_t WS_MIX = 196 * MiB;
constexpr size_t WS_END = 230 * MiB;
constexpr int CW_BAR = 1024;
static_assert((CW_BAR + XCD_BAR_WORDS) * 4 <= (int)CTL_ZERO_BYTES, "ctl");
constexpr int RING_BYTES = 131072, MISC_OFF = RING_BYTES + 320, LDS_BYTES = 147456;

__device__ __forceinline__ float bf2f(unsigned short b) { return __builtin_bit_cast(float, (unsigned)b << 16); }
__device__ __forceinline__ float bflo(unsigned w) { return __builtin_bit_cast(float, w << 16); }
__device__ __forceinline__ float bfhi(unsigned w) { return __builtin_bit_cast(float, w & 0xffff0000u); }
__device__ __forceinline__ unsigned pkbf(float lo, float hi) { return pg8::cvt_pk_bf16(lo, hi); }
__device__ __forceinline__ float wave_sum(float v) {
#pragma unroll
    for (int o = 1; o < 64; o <<= 1) v += __shfl_xor(v, o);
    return v;
}
__device__ __forceinline__ float sigmoidf_(float x) { return 1.0f / (1.0f + __expf(-x)); }

struct Args { const float* in[31]; float* out; unsigned char* ws; };
enum { I_XP = 0, I_XS, I_SWKV, I_SSH, I_SCV, I_LN1G, I_LN1B, I_F1G, I_F1U, I_F1D, I_WIN, I_MU, I_W0, I_WLU, I_A0, I_ALU, I_GLU, I_KK, I_KA, I_RK, I_LNXG, I_LNXB, I_CW, I_WOUT,
       I_LN2G, I_LN2B, I_F2G, I_F2U, I_F2D, I_LN3G, I_LN3B };

namespace pg8 {
struct EpiSwiGLU {
    static constexpr bool PERM = true, AFTER_DRAIN = false;
    bf16_t* O; int ldc;
    __device__ __forceinline__ void operator()(const f32x4 (&acc)[2][2][4][2], const Unit& u, int wr, int wc, int fr, int fq) const {
        const int row0 = u.pm * BM + wr * 64 + fr, col0 = u.pn * 128 + wc * 32 + 8 * fq;
#pragma unroll
        for (int ai = 0; ai < 2; ++ai)
#pragma unroll
            for (int m = 0; m < 4; ++m) { bf16_t* rowp = O + (size_t)(row0 + ai * HALF + m * 16) * ldc + col0; float hv[8];
#pragma unroll
                for (int n = 0; n < 2; ++n)
#pragma unroll
                    for (int e = 0; e < 4; ++e) { const float g = acc[ai][0][m][n][e], up = acc[ai][1][m][n][e]; hv[n * 4 + e] = g * __builtin_amdgcn_rcpf(1.0f + __expf(-g)) * up; }
                u32x4 w; w.x = cvt_pk_bf16(hv[0], hv[1]); w.y = cvt_pk_bf16(hv[2], hv[3]); w.z = cvt_pk_bf16(hv[4], hv[5]); w.w = cvt_pk_bf16(hv[6], hv[7]);
                *(u32x4*)rowp = w; }
    }
};
template <bool RES_BF16> struct EpiRes {
    static constexpr bool PERM = false, AFTER_DRAIN = false;
    const void* r0; const void* r1; int split_pm; float* out; int ldc; float alpha, beta;
    __device__ __forceinline__ void operator()(const f32x4 (&acc)[2][2][4][2], const Unit& u, int wr, int wc, int fr, int fq) const {
        const int col0 = u.pn * BM + wc * 32 + 4 * fq;
        const char* rb = (const char*)(u.pm < split_pm ? r0 : r1); const int rrow0 = (u.pm < split_pm ? u.pm : u.pm - split_pm) * BM;
#pragma unroll
        for (int ai = 0; ai < 2; ++ai)
#pragma unroll
            for (int m = 0; m < 4; ++m) { const int rl = ai * HALF + wr * 64 + m * 16 + fr; const size_t off = (size_t)(u.pm * BM + rl) * ldc + col0; const size_t roff = (size_t)(rrow0 + rl) * ldc + col0;
#pragma unroll
                for (int bj = 0; bj < 2; ++bj)
#pragma unroll
                    for (int n = 0; n < 2; ++n) { f32x4 rv;
                        if (RES_BF16) { typedef unsigned u32x2v __attribute__((ext_vector_type(2))); const u32x2v w = *(const u32x2v*)(rb + (roff + bj * HALF + n * 16) * 2);
                            rv = (f32x4){__builtin_bit_cast(float, w.x << 16), __builtin_bit_cast(float, w.x & 0xffff0000u), __builtin_bit_cast(float, w.y << 16), __builtin_bit_cast(float, w.y & 0xffff0000u)}; }
                        else rv = *(const f32x4*)(rb + (roff + bj * HALF + n * 16) * 4);
                        *(f32x4*)(out + off + bj * HALF + n * 16) = rv * alpha + acc[ai][bj][m][n] * beta; } }
    }
};
}

struct Frame {
    LAS unsigned char* lds; int tid, lane, wave, gw, NGW, G;
};

__device__ __forceinline__ void p0_transpose_item(const float* W, int N, bf16* WT, int ldt, int coff, int drow0, LAS float* scr, int k0, int n0, int lane) {
#pragma unroll 8
    for (int i = 0; i < 32; ++i) { const int kk = 2 * i + (lane >> 5); scr[kk * 33 + (lane & 31)] = W[(size_t)(k0 + kk) * N + n0 + (lane & 31)]; }
    LDS_WAIT(); asm volatile("" ::: "memory");
    const int c = lane & 7;
#pragma unroll
    for (int j = 0; j < 4; ++j) { const int n = (lane >> 3) + 8 * j; const LAS float* s = scr + (8 * c) * 33 + n;
        v4u o; o.x = pkbf(s[0 * 33], s[1 * 33]); o.y = pkbf(s[2 * 33], s[3 * 33]); o.z = pkbf(s[4 * 33], s[5 * 33]); o.w = pkbf(s[6 * 33], s[7 * 33]);
        *(GAS v4u*)(WT + (size_t)(drow0 + n) * ldt + coff + k0 + 8 * c) = o; }
    LDS_WAIT(); asm volatile("" ::: "memory");
}

__device__ __forceinline__ void phase_prologue(const Args& A, Frame& F) {
    unsigned char* ws = A.ws;
    LAS float* scr = (LAS float*)(F.lds + F.wave * 16384);
    constexpr int I_GU = 16 * 88, I_DN = 44 * 32, I_IN = 16 * 104, I_OUT = 16 * 32, I_L64 = 16, I_L128 = 32;
    constexpr int NITEMS = 6 * I_GU + I_IN + I_OUT + 2 * I_L64 + I_L128;
    static_assert(I_GU == I_DN, "");
    for (int it = F.gw; it < NITEMS; it += F.NGW) {
        int r = it;
        if (r < 6 * I_GU) { const int mtx = r / I_GU; r -= mtx * I_GU; const int f2 = mtx >= 3, kind = mtx % 3;
            if (kind < 2) { const int nblk = FF / 32, kb = r / nblk, nb = r % nblk, n0 = nb * 32; const int drow = (n0 >> 7) * 256 + (n0 & 127) + kind * 128;
                p0_transpose_item(A.in[(f2 ? I_F2G : I_F1G) + kind], FF, (bf16*)(ws + (f2 ? WS_WGU2 : WS_WGU1)), D, 0, drow, scr, kb * 64, n0, F.lane); }
            else { const int nblk = D / 32, kb = r / nblk, nb = r % nblk;
                p0_transpose_item(A.in[f2 ? I_F2D : I_F1D], D, (bf16*)(ws + (f2 ? WS_WD2 : WS_WD1)), FF, 0, nb * 32, scr, kb * 64, nb * 32, F.lane); }
            continue; }
        r -= 6 * I_GU;
        if (r < I_IN) { const int nblk = PTOT / 32, kb = r / nblk, nb = r % nblk; p0_transpose_item(A.in[I_WIN], PTOT, (bf16*)(ws + WS_WIN), D, 0, nb * 32, scr, kb * 64, nb * 32, F.lane); continue; }
        r -= I_IN;
        if (r < I_OUT) { const int nblk = D / 32, kb = r / nblk, nb = r % nblk; p0_transpose_item(A.in[I_WOUT], D, (bf16*)(ws + WS_WOUT), D, 0, nb * 32, scr, kb * 64, nb * 32, F.lane); continue; }
        r -= I_OUT;
        if (r < I_L64) { p0_transpose_item(A.in[I_WLU], 512, (bf16*)(ws + WS_WL), KLORA, 0, r * 32, scr, 0, r * 32, F.lane); continue; }
        r -= I_L64;
        if (r < I_L64) { p0_transpose_item(A.in[I_ALU], 512, (bf16*)(ws + WS_WL), KLORA, 64, 512 + r * 32, scr, 0, r * 32, F.lane); continue; }
        r -= I_L64;
        { const int kb = r / 16, nb = r % 16; p0_transpose_item(A.in[I_GLU], 512, (bf16*)(ws + WS_WL), KLORA, 128, 1024 + nb * 32, scr, kb * 64, nb * 32, F.lane); }
    }
    { const int gt = F.gw * 64 + F.lane, NT = F.NGW * 64;
      for (int ch = gt; ch < NLORA * KLORA / 8; ch += NT) { const int row = ch >> 5, col = (ch & 31) * 8; const int ty = row >> 9;
          const bool nz = ty == 0 ? (col < 64) : (ty == 1 ? (col >= 64 && col < 128) : (col >= 128));
          if (!nz) *(GAS v4u*)((bf16*)(ws + WS_WL) + (size_t)row * KLORA + col) = (v4u){0u, 0u, 0u, 0u}; } }
    for (int m = F.gw; m < M; m += F.NGW) {
        const float* xrow = m < MP ? A.in[I_XP] + (size_t)m * D : A.in[I_XS] + (size_t)(m - MP) * D;
        const GAS f32x4* xr = (const GAS f32x4*)xrow + F.lane; GAS unsigned long long* o8 = (GAS unsigned long long*)((bf16*)(ws + WS_XB) + (size_t)m * D) + F.lane;
#pragma unroll
        for (int j = 0; j < 4; ++j) { const f32x4 v = xr[64 * j]; o8[64 * j] = (unsigned long long)pkbf(v.x, v.y) | ((unsigned long long)pkbf(v.z, v.w) << 32); }
    }
}

template <bool FINAL> __device__ __forceinline__ void phase_ln(Frame& F, float* z, bf16* xb, const float* g, const float* b) {
    f32x4 gv[4], bv[4];
#pragma unroll
    for (int j = 0; j < 4; ++j) { gv[j] = ((const GAS f32x4*)g)[F.lane + 64 * j]; bv[j] = ((const GAS f32x4*)b)[F.lane + 64 * j]; }
    for (int m = F.gw; m < M; m += F.NGW) {
        GAS f32x4* xr = (GAS f32x4*)(z + (size_t)m * D) + F.lane;
        f32x4 v[4]; float s = 0.f;
#pragma unroll
        for (int j = 0; j < 4; ++j) { v[j] = xr[64 * j]; s += (v[j].x + v[j].y) + (v[j].z + v[j].w); }
        const float mean = wave_sum(s) * (1.f / D); float s2 = 0.f;
#pragma unroll
        for (int j = 0; j < 4; ++j) { v[j] = v[j] - mean; s2 += (v[j].x * v[j].x + v[j].y * v[j].y) + (v[j].z * v[j].z + v[j].w * v[j].w); }
        const float rstd = 1.f / sqrtf(wave_sum(s2) * (1.f / D) + LN_EPS);
        if (FINAL) {
#pragma unroll
            for (int j = 0; j < 4; ++j) xr[64 * j] = v[j] * rstd * gv[j] + bv[j];
        } else {
            GAS unsigned long long* o8 = (GAS unsigned long long*)(xb + (size_t)m * D) + F.lane;
#pragma unroll
            for (int j = 0; j < 4; ++j) { const f32x4 o = v[j] * rstd * gv[j] + bv[j]; o8[64 * j] = (unsigned long long)pkbf(o.x, o.y) | ((unsigned long long)pkbf(o.z, o.w) << 32); }
        }
    }
}

struct Tok { int s, t, T; bool prompt; };
__device__ __forceinline__ Tok tok_of(int n) { Tok k; k.prompt = n < MP; if (k.prompt) { k.s = n >> 11; k.t = n & 2047; k.T = 2048; } else { const int r = n - MP; k.s = r >> 2; k.t = r & 3; k.T = 4; } return k; }

__device__ __forceinline__ void phase_prep(const Args& A, Frame& F) {
    unsigned char* ws = A.ws; const bf16* proj = (const bf16*)(ws + WS_PROJ); bf16* ap = (bf16*)(ws + WS_AP); bf16* mix = (bf16*)(ws + WS_MIX);
    const int lane = F.lane;
    const f32x4 mu4 = *(const GAS f32x4*)(A.in[I_MU] + OFF_WD + 4 * lane);
    float cw[3][8];
#pragma unroll
    for (int i = 0; i < 3; ++i)
#pragma unroll
        for (int e = 0; e < 8; ++e) cw[i][e] = A.in[I_CW][i * 512 + 8 * lane + e];
    typedef unsigned u32x2v __attribute__((ext_vector_type(2)));
    for (int n = F.gw; n < M; n += F.NGW) {
        const Tok k = tok_of(n); const bf16* pr = proj + (size_t)n * PTOT;
        { const u32x2v c = *(const GAS u32x2v*)(pr + OFF_WD + 4 * lane); f32x4 cur = (f32x4){bflo(c.x), bfhi(c.x), bflo(c.y), bfhi(c.y)}, prev;
          if (k.t > 0) { const u32x2v p = *(const GAS u32x2v*)(pr - PTOT + OFF_WD + 4 * lane); prev = (f32x4){bflo(p.x), bfhi(p.x), bflo(p.y), bfhi(p.y)}; }
          else if (!k.prompt) prev = *(const GAS f32x4*)(A.in[I_SSH] + (size_t)k.s * PSH + OFF_WD + 4 * lane);
          else prev = (f32x4){0.f, 0.f, 0.f, 0.f};
          f32x4 m = cur + mu4 * (prev - cur);
          if (lane < 16) { m.x = tanhf(m.x); m.y = tanhf(m.y); m.z = tanhf(m.z); m.w = tanhf(m.w); }
          else if (lane >= 32) { m.x = sigmoidf_(m.x); m.y = sigmoidf_(m.y); m.z = sigmoidf_(m.z); m.w = sigmoidf_(m.w); }
          u32x2v o; o.x = pkbf(m.x, m.y); o.y = pkbf(m.z, m.w); *(GAS u32x2v*)(ap + (size_t)n * KLORA + 4 * lane) = o; }
        { const v4u cbw = *(const GAS v4u*)(pr + OFF_CB + 8 * lane), ccw = *(const GAS v4u*)(pr + OFF_CC + 8 * lane), chw = *(const GAS v4u*)(pr + OFF_CH + 8 * lane);
          float u2[8], u1[8], u0[8], cb[8];
#pragma unroll
          for (int e = 0; e < 4; ++e) { u2[2 * e] = bflo(ccw[e]) * bflo(chw[e]); u2[2 * e + 1] = bfhi(ccw[e]) * bfhi(chw[e]); cb[2 * e] = bflo(cbw[e]); cb[2 * e + 1] = bfhi(cbw[e]); }
          const float* sc = A.in[I_SCV] + (size_t)k.s * 1024 + 8 * lane;
          if (k.t >= 1) { const v4u a = *(const GAS v4u*)(pr - PTOT + OFF_CC + 8 * lane), b = *(const GAS v4u*)(pr - PTOT + OFF_CH + 8 * lane);
#pragma unroll
              for (int e = 0; e < 4; ++e) { u1[2 * e] = bflo(a[e]) * bflo(b[e]); u1[2 * e + 1] = bfhi(a[e]) * bfhi(b[e]); } }
          else {
#pragma unroll
              for (int e = 0; e < 8; ++e) u1[e] = k.prompt ? 0.f : sc[512 + e]; }
          if (k.t >= 2) { const v4u a = *(const GAS v4u*)(pr - 2 * PTOT + OFF_CC + 8 * lane), b = *(const GAS v4u*)(pr - 2 * PTOT + OFF_CH + 8 * lane);
#pragma unroll
              for (int e = 0; e < 4; ++e) { u0[2 * e] = bflo(a[e]) * bflo(b[e]); u0[2 * e + 1] = bfhi(a[e]) * bfhi(b[e]); } }
          else {
#pragma unroll
              for (int e = 0; e < 8; ++e) u0[e] = k.prompt ? 0.f : sc[k.t * 512 + e]; }
          float y[8];
#pragma unroll
          for (int e = 0; e < 8; ++e) y[e] = cb[e] * (cw[0][e] * u0[e] + cw[1][e] * u1[e] + cw[2][e] * u2[e]);
          v4u o; o.x = pkbf(y[0], y[1]); o.y = pkbf(y[2], y[3]); o.z = pkbf(y[4], y[5]); o.w = pkbf(y[6], y[7]);
          *(GAS v4u*)(mix + (size_t)n * D + 512 + 8 * lane) = o;
          if (k.t >= k.T - 2) { float* co = A.out + (k.prompt ? O_CVP : O_CVS) + ((size_t)k.s * 2 + (k.t - (k.T - 2))) * 512 + 8 * lane;
              *(GAS f32x4*)co = (f32x4){u2[0], u2[1], u2[2], u2[3]}; *(GAS f32x4*)(co + 4) = (f32x4){u2[4], u2[5], u2[6], u2[7]}; } }
        if (k.t == k.T - 1) { float* so = A.out + (k.prompt ? O_SHP : O_SHS) + (size_t)k.s * PSH;
#pragma unroll
            for (int i = 0; i < 7; ++i) { const u32x2v c = *(const GAS u32x2v*)(pr + 256 * i + 4 * lane); *(GAS f32x4*)(so + 256 * i + 4 * lane) = (f32x4){bflo(c.x), bfhi(c.x), bflo(c.y), bfhi(c.y)}; } }
    }
}

constexpr int TC = 32, RB_FLOATS = TC * 384;
__device__ __forceinline__ float row16_allsum(float x) {
    x += __builtin_bit_cast(float, __builtin_amdgcn_update_dpp(0, __builtin_bit_cast(int, x), 0x128, 0xf, 0xf, false));
    x += __builtin_bit_cast(float, __builtin_amdgcn_update_dpp(0, __builtin_bit_cast(int, x), 0x124, 0xf, 0xf, false));
    x += __builtin_bit_cast(float, __builtin_amdgcn_update_dpp(0, __builtin_bit_cast(int, x), 0x122, 0xf, 0xf, false));
    x += __builtin_bit_cast(float, __builtin_amdgcn_update_dpp(0, __builtin_bit_cast(int, x), 0x121, 0xf, 0xf, false));
    return x;
}
struct RecItem { int n0, ntok, s, h, q; bool prompt; };
__device__ __forceinline__ RecItem rec_item(int b, int i) {
    RecItem it;
    if (i < 64) { it.prompt = true; it.s = b >> 5; it.h = (b >> 2) & 7; it.q = b & 3; it.n0 = it.s * 2048 + TC * i; it.ntok = TC; }
    else { const int su = b * 4 + (i - 64); it.prompt = false; it.s = su >> 3; it.h = su & 7; it.q = 0; it.n0 = MP + it.s * 4; it.ntok = 4; }
    return it;
}
__device__ __forceinline__ void rec_produce(const Args& A, const RecItem& it, LAS float* buf, int pw, int lane) {
    unsigned char* ws = A.ws; const bf16* proj = (const bf16*)(ws + WS_PROJ);
    const bf16* lora = (const bf16*)A.out;
    float* bonus = (float*)(ws + WS_BONUS);
    const int c = it.h * 64 + lane;
    const float mur = A.in[I_MU][c], muk = A.in[I_MU][512 + c], muv = A.in[I_MU][1024 + c], kkp = A.in[I_KK][c], kap = A.in[I_KA][c], rkp = A.in[I_RK][c], w0p = A.in[I_W0][c], a0p = A.in[I_A0][c];
#pragma unroll 4
    for (int tt = pw; tt < it.ntok; tt += 4) {
        const int n = it.n0 + tt; const int t = it.prompt ? (n & 2047) : tt;
        const bf16* pr = proj + (size_t)n * PTOT + c;
        const float rc = bf2f(pr[0]), kc = bf2f(pr[512]), vc = bf2f(pr[1024]);
        float rp = 0.f, kp = 0.f, vp = 0.f;
        if (t > 0) { rp = bf2f(pr[-PTOT]); kp = bf2f(pr[512 - PTOT]); vp = bf2f(pr[1024 - PTOT]); }
        else if (!it.prompt) { const float* ss = A.in[I_SSH] + (size_t)it.s * PSH + c; rp = ss[0]; kp = ss[512]; vp = ss[1024]; }
        const float a = sigmoidf_(a0p + bf2f(lora[(size_t)n * NLORA + 512 + c])), w = __expf(-0.6065306597126334f * sigmoidf_(w0p + bf2f(lora[(size_t)n * NLORA + c])));
        const float r = rc + mur * (rp - rc), k = kc + muk * (kp - kc), v = vc + muv * (vp - vc);
        const float kkr = k * kkp; const float ss2 = wave_sum(kkr * kkr); const float kk = kkr / fmaxf(sqrtf(ss2), 1e-12f);
        const float k2 = k * (1.0f + (a - 1.0f) * kap), nb = -kk * a;
        const float bon = wave_sum(r * k2 * rkp);
        if (lane == 0 && it.q == 0) bonus[(size_t)n * 8 + it.h] = bon;
        LAS float* bt = buf + tt * 384;
        bt[lane] = r; bt[64 + lane] = w; bt[128 + lane] = k2; bt[192 + lane] = v; bt[256 + lane] = kk; bt[320 + lane] = nb;
    }
}
#define REC_STEP(S, bt, vi, oval) do { \
    const f32x4 kk4 = *(const LAS f32x4*)((bt) + 256 + 4 * l), w4 = *(const LAS f32x4*)((bt) + 64 + 4 * l), nb4 = *(const LAS f32x4*)((bt) + 320 + 4 * l), \
                k4 = *(const LAS f32x4*)((bt) + 128 + 4 * l), r4 = *(const LAS f32x4*)((bt) + 4 * l); \
    float d_ = (S.x * kk4.x + S.y * kk4.y) + (S.z * kk4.z + S.w * kk4.w); d_ = row16_allsum(d_); \
    S = S * w4 + nb4 * d_ + k4 * (vi); \
    float o_ = (S.x * r4.x + S.y * r4.y) + (S.z * r4.z + S.w * r4.w); oval = row16_allsum(o_); } while (0)

__device__ __forceinline__ void phase_recurrence(const Args& A, Frame& F) {
    LAS float* bufs = (LAS float*)F.lds;
    LAS float* obuf = (LAS float*)(F.lds + 2 * RB_FLOATS * 4) + (F.wave & 3) * (TC * 16);
    bf16* mix = (bf16*)(A.ws + WS_MIX);
    const int b = blockIdx.x, lane = F.lane, w = F.wave, l = lane & 15, rg = lane >> 4;
    constexpr int NIT = 68;
    f32x4 S = (f32x4){0.f, 0.f, 0.f, 0.f};
    if (w >= 4) { const RecItem it0 = rec_item(b, 0); rec_produce(A, it0, bufs, w - 4, lane); }
    __syncthreads();
    for (int i = 0; i < NIT; ++i) {
        if (w >= 4) { if (i + 1 < NIT) { const RecItem itn = rec_item(b, i + 1); rec_produce(A, itn, bufs + ((i + 1) & 1) * RB_FLOATS, w - 4, lane); } }
        else {
            const RecItem it = rec_item(b, i); const LAS float* buf = bufs + (i & 1) * RB_FLOATS;
            if (it.prompt) {
                const int irow = it.q * 16 + w * 4 + rg;
#pragma unroll 4
                for (int t = 0; t < TC; ++t) { const LAS float* bt = buf + t * 384; const float vi = bt[192 + irow]; float o; REC_STEP(S, bt, vi, o); if (l == 0) obuf[t * 4 + rg] = o; }
                LDS_WAIT(); asm volatile("" ::: "memory");
                { const int t = lane >> 1, pr2 = lane & 1; const float o0 = obuf[t * 4 + 2 * pr2], o1 = obuf[t * 4 + 2 * pr2 + 1];
                  *(GAS unsigned*)(mix + (size_t)(it.n0 + t) * D + it.h * 64 + it.q * 16 + w * 4 + 2 * pr2) = pkbf(o0, o1); }
                if (i == 63) *(GAS f32x4*)(A.out + O_WKVP + ((size_t)(it.s * 8 + it.h) * 64 + irow) * 64 + 4 * l) = S;
                LDS_WAIT(); asm volatile("" ::: "memory");
            } else {
                f32x4 Sq[4];
#pragma unroll
                for (int qq = 0; qq < 4; ++qq) Sq[qq] = *(const GAS f32x4*)(A.in[I_SWKV] + ((size_t)(it.s * 8 + it.h) * 64 + qq * 16 + w * 4 + rg) * 64 + 4 * l);
#pragma unroll
                for (int qq = 0; qq < 4; ++qq) { const int irow = qq * 16 + w * 4 + rg;
#pragma unroll
                    for (int t = 0; t < 4; ++t) { const LAS float* bt = buf + t * 384; const float vi = bt[192 + irow]; float o; REC_STEP(Sq[qq], bt, vi, o); if (l == 0) obuf[t * 16 + qq * 4 + rg] = o; }
                    *(GAS f32x4*)(A.out + O_WKVS + ((size_t)(it.s * 8 + it.h) * 64 + irow) * 64 + 4 * l) = Sq[qq]; }
                LDS_WAIT(); asm volatile("" ::: "memory");
                { const int t = lane >> 4, x = lane & 15; const float o = obuf[t * 16 + x];
                  mix[(size_t)(it.n0 + t) * D + it.h * 64 + (x >> 2) * 16 + w * 4 + (x & 3)] = (bf16)(pkbf(o, 0.f) & 0xffffu); }
                LDS_WAIT(); asm volatile("" ::: "memory");
            }
        }
        __syncthreads();
    }
}

__device__ __forceinline__ void phase_post(const Args& A, Frame& F) {
    unsigned char* ws = A.ws; const bf16* proj = (const bf16*)(ws + WS_PROJ); bf16* mix = (bf16*)(ws + WS_MIX);
    const bf16* recg = (const bf16*)A.out + 1024;   const float* bonus = (const float*)(ws + WS_BONUS);
    const int lane = F.lane, c0 = 8 * lane, h = lane >> 3;
    float muv[8], lg[8], lb[8];
#pragma unroll
    for (int e = 0; e < 8; ++e) { muv[e] = A.in[I_MU][OFF_V + c0 + e]; lg[e] = A.in[I_LNXG][c0 + e]; lb[e] = A.in[I_LNXB][c0 + e]; }
    for (int n = F.gw; n < M; n += F.NGW) {
        const Tok k = tok_of(n);
        const v4u ow = *(const GAS v4u*)(mix + (size_t)n * D + c0), gw4 = *(const GAS v4u*)(recg + (size_t)n * NLORA + c0), vcw = *(const GAS v4u*)(proj + (size_t)n * PTOT + OFF_V + c0);
        float o[8], g[8], v[8], vp[8];
#pragma unroll
        for (int e = 0; e < 4; ++e) { o[2 * e] = bflo(ow[e]); o[2 * e + 1] = bfhi(ow[e]); g[2 * e] = bflo(gw4[e]); g[2 * e + 1] = bfhi(gw4[e]); v[2 * e] = bflo(vcw[e]); v[2 * e + 1] = bfhi(vcw[e]); }
        if (k.t > 0) { const v4u pw4 = *(const GAS v4u*)(proj + (size_t)(n - 1) * PTOT + OFF_V + c0);
#pragma unroll
            for (int e = 0; e < 4; ++e) { vp[2 * e] = bflo(pw4[e]); vp[2 * e + 1] = bfhi(pw4[e]); } }
        else {
#pragma unroll
            for (int e = 0; e < 8; ++e) vp[e] = k.prompt ? 0.f : A.in[I_SSH][(size_t)k.s * PSH + OFF_V + c0 + e]; }
        float s = 0.f;
#pragma unroll
        for (int e = 0; e < 8; ++e) s += o[e];
        s += __shfl_xor(s, 1); s += __shfl_xor(s, 2); s += __shfl_xor(s, 4);
        const float mean = s * (1.f / 64.f); float q = 0.f;
#pragma unroll
        for (int e = 0; e < 8; ++e) { o[e] -= mean; q += o[e] * o[e]; }
        q += __shfl_xor(q, 1); q += __shfl_xor(q, 2); q += __shfl_xor(q, 4);
        const float rstd = 1.0f / sqrtf(q * (1.f / 64.f) + GN_EPS); const float bon = bonus[(size_t)n * 8 + h];
        float y[8];
#pragma unroll
        for (int e = 0; e < 8; ++e) { const float vm = v[e] + muv[e] * (vp[e] - v[e]); y[e] = (o[e] * rstd * lg[e] + lb[e] + bon * vm) * g[e]; }
        v4u ov; ov.x = pkbf(y[0], y[1]); ov.y = pkbf(y[2], y[3]); ov.z = pkbf(y[4], y[5]); ov.w = pkbf(y[6], y[7]);
        *(GAS v4u*)(mix + (size_t)n * D + c0) = ov;
    }
}

__global__ void __launch_bounds__(NWAVES * 64, 2) mk_fwd(Args A) {
    extern __shared__ __attribute__((aligned(16))) unsigned char lds_raw[];
    Frame F; F.lds = (LAS unsigned char*)lds_raw; F.tid = threadIdx.x; F.lane = F.tid & 63; F.wave = __builtin_amdgcn_readfirstlane(F.tid >> 6);
    F.G = gridDim.x; F.gw = blockIdx.x * NWAVES + F.wave; F.NGW = F.G * NWAVES;
    volatile LAS unsigned* MISC = (volatile LAS unsigned*)(F.lds + MISC_OFF);
    for (int u = F.tid; u < (LDS_BYTES - RING_BYTES) / 4; u += NWAVES * 64) ((LAS unsigned*)(F.lds + RING_BYTES))[u] = 0u;
    __syncthreads();
    unsigned char* ws = A.ws;
    XcdBarrier bar = xcd_barrier_post((unsigned*)(ws + WS_CTL) + CW_BAR, MISC + 8);
#define GRID_BAR() xcd_barrier(bar)
    bf16* XB = (bf16*)(ws + WS_XB); bf16* HB = (bf16*)(ws + WS_H); bf16* PROJ = (bf16*)(ws + WS_PROJ); bf16* AP = (bf16*)(ws + WS_AP); bf16* MIX = (bf16*)(ws + WS_MIX);
    float* Z = A.out + O_Y;
    LAS unsigned char* ring = F.lds;

#ifndef PHMASK
#define PHMASK 0xFFFF
#endif
#if (PHMASK >> 0) & 1
    phase_prologue(A, F); GRID_BAR();
#endif
#if (PHMASK >> 1) & 1
    { pg8::Gemm g{XB, (const bf16*)(ws + WS_WGU1), M, NGU, D}; pg8::StaticOrder S; S.init(M, NGU, F.G, (int)blockIdx.x); pg8::EpiSwiGLU E{HB, FF};
      pg8::gemm_phase<pg8::EpiSwiGLU, pg8::StaticOrder, true, true>(ring, g, S, E); }
#endif
    GRID_BAR();
#if (PHMASK >> 2) & 1
    { pg8::Gemm g{HB, (const bf16*)(ws + WS_WD1), M, D, FF}; pg8::StaticOrder S; S.init(M, D, F.G, (int)blockIdx.x); pg8::EpiRes<false> E{A.in[I_XP], A.in[I_XS], MP / 256, Z, D, ALPHA, 0.5f};
      pg8::gemm_phase<pg8::EpiRes<false>, pg8::StaticOrder, true, true>(ring, g, S, E); }
#endif
    GRID_BAR();
#if (PHMASK >> 3) & 1
    phase_ln<false>(F, Z, XB, A.in[I_LN1G], A.in[I_LN1B]); GRID_BAR();
#endif
#if (PHMASK >> 4) & 1
    { pg8::Gemm g{XB, (const bf16*)(ws + WS_WIN), M, PTOT, D}; pg8::StaticOrder S; S.init(M, PTOT, F.G, (int)blockIdx.x); pg8::EpiBf16<0> E{PROJ, PTOT, nullptr, 0, 0, 1.f};
      pg8::gemm_phase<pg8::EpiBf16<0>, pg8::StaticOrder, true, true>(ring, g, S, E); }
#endif
    GRID_BAR();
#if (PHMASK >> 5) & 1
    phase_prep(A, F); GRID_BAR();
#endif
#if (PHMASK >> 6) & 1
    { pg8::Gemm g{AP, (const bf16*)(ws + WS_WL), M, NLORA, KLORA}; pg8::StaticOrder S; S.init(M, NLORA, F.G, (int)blockIdx.x);
      pg8::EpiBf16<0> E{(bf16*)A.out, NLORA, nullptr, 0, 0, 1.f};
      pg8::gemm_phase<pg8::EpiBf16<0>, pg8::StaticOrder, true, true>(ring, g, S, E); }
#endif
    GRID_BAR();
#if (PHMASK >> 7) & 1
    phase_recurrence(A, F); GRID_BAR();
#endif
#if (PHMASK >> 8) & 1
    phase_post(A, F); GRID_BAR();
#endif
#if (PHMASK >> 9) & 1
    { pg8::Gemm g{MIX, (const bf16*)(ws + WS_WOUT), M, D, D}; pg8::StaticOrder S; S.init(M, D, F.G, (int)blockIdx.x); pg8::EpiRes<true> E{XB, XB, 1 << 30, Z, D, ALPHA, 1.0f};
      pg8::gemm_phase<pg8::EpiRes<true>, pg8::StaticOrder, true, true>(ring, g, S, E); }
#endif
    GRID_BAR();
#if (PHMASK >> 10) & 1
    phase_ln<false>(F, Z, XB, A.in[I_LN2G], A.in[I_LN2B]); GRID_BAR();
#endif
#if (PHMASK >> 11) & 1
    { pg8::Gemm g{XB, (const bf16*)(ws + WS_WGU2), M, NGU, D}; pg8::StaticOrder S; S.init(M, NGU, F.G, (int)blockIdx.x); pg8::EpiSwiGLU E{HB, FF};
      pg8::gemm_phase<pg8::EpiSwiGLU, pg8::StaticOrder, true, true>(ring, g, S, E); }
#endif
    GRID_BAR();
#if (PHMASK >> 12) & 1
    { pg8::Gemm g{HB, (const bf16*)(ws + WS_WD2), M, D, FF}; pg8::StaticOrder S; S.init(M, D, F.G, (int)blockIdx.x); pg8::EpiRes<true> E{XB, XB, 1 << 30, Z, D, ALPHA, 0.5f};
      pg8::gemm_phase<pg8::EpiRes<true>, pg8::StaticOrder, true, true>(ring, g, S, E); }
#endif
    GRID_BAR();
#if (PHMASK >> 13) & 1
    phase_ln<true>(F, Z, XB, A.in[I_LN3G], A.in[I_LN3B]);
#endif
}

extern "C" void kernel_launch(void* const* d_in, const int* in_sizes, int n_in, void* d_out, int out_size, void* d_ws, size_t ws_size, hipStream_t stream) {
    static int grid = 0;
    if (grid == 0) {
        if (n_in != 31 || out_size != (int)O_END || ws_size < WS_END) { fprintf(stderr, "kernel_launch: unexpected sizes n_in %d out %d ws %zu\n", n_in, out_size, ws_size); grid = -1; return; }
        int dev = 0, cus = 0, per_cu = 0;
        if (hipGetDevice(&dev) != hipSuccess || hipDeviceGetAttribute(&cus, hipDeviceAttributeMultiprocessorCount, dev) != hipSuccess) { grid = -1; return; }
        if (hipFuncSetAttribute((const void*)mk_fwd, hipFuncAttributeMaxDynamicSharedMemorySize, LDS_BYTES) != hipSuccess) { fprintf(stderr, "kernel_launch: hipFuncSetAttribute failed\n"); grid = -1; return; }
        if (hipOccupancyMaxActiveBlocksPerMultiprocessor(&per_cu, (const void*)mk_fwd, NWAVES * 64, LDS_BYTES) != hipSuccess || per_cu < 1) { fprintf(stderr, "kernel_launch: occupancy query says %d\n", per_cu); (void)hipGetLastError(); grid = -1; return; }
        if (cus != 256) { fprintf(stderr, "kernel_launch: built for 256 CUs, found %d\n", cus); grid = -1; return; }
        grid = 256;
    }
    if (grid < 0) return;
    (void)hipMemsetAsync((char*)d_ws + WS_CTL, 0, CTL_ZERO_BYTES, stream);
    Args a{};
    for (int i = 0; i < 31; ++i) a.in[i] = (const float*)d_in[i];
    a.out = (float*)d_out; a.ws = (unsigned char*)d_ws;
    hipLaunchKernelGGL(mk_fwd, dim3(grid), dim3(NWAVES * 64), LDS_BYTES, stream, a);
}
```

```cpp
#include <hip/hip_runtime.h>
#include <cstdio>
#include <cstdint>
namespace pg8 {
#define PG8_LAS __attribute__((address_space(3)))
typedef unsigned short bf16_t;
typedef short bf16x8 __attribute__((ext_vector_type(8)));
typedef float f32x4 __attribute__((ext_vector_type(4)));
typedef unsigned u32x4 __attribute__((ext_vector_type(4)));
constexpr int BM = 256, BK = 64, HALF = 128, HTB = HALF * BK * 2  , STAGE_BYTES = 8 * HTB, NXCD = 8, WGM = 8;

__host__ __device__ __forceinline__ int lds_byte(int r, int c) { const int st = (r >> 4) * 2 + (c >> 5), rr = r & 15, cc = c & 31, ob = rr * 64 + cc * 2; return st * 1024 + (ob ^ (((ob >> 9) & 1) << 5)); }
__host__ __device__ __forceinline__ void stage_rc(int b, int& R, int& C) { const int st = b / 1024, sb = b % 1024, swz = sb ^ (((sb >> 9) & 1) << 5); R = (st >> 1) * 16 + swz / 64; C = (st & 1) * 32 + (swz % 64) / 2; }
__host__ __device__ __forceinline__ int perm32(int rho) { const int n = rho >> 4, i = rho & 15; return 8 * (i >> 2) + 4 * n + (i & 3); }

struct Unit { int pm, pn; };
struct Gemm { const bf16_t* A; const bf16_t* Bt; int M, N, K; };

struct StaticOrder {
    int nM, nN, nwg, G, c;
    __host__ __device__ void init(int M, int N, int G_, int c_) { nM = M / BM; nN = N / BM; nwg = nM * nN; G = G_; c = c_; }
    __host__ __device__ bool next(int i, Unit& u) const {
        const long L = (long)i * G + c; if (L >= nwg) return false;
        int wgid = (int)L; { const int q = nwg / NXCD, r = nwg % NXCD, xcd = wgid % NXCD, off = wgid / NXCD; wgid = (xcd < r ? xcd * (q + 1) : r * (q + 1) + (xcd - r) * q) + off; }
        const int nig = WGM * nN, gid = wgid / nig, fm = gid * WGM, gsz = (nM - fm) < WGM ? (nM - fm) : WGM;
        u.pm = fm + ((wgid % nig) % gsz); u.pn = (wgid % nig) / gsz; return true;
    }
    __device__ __forceinline__ void a_ready(const Unit&) const {}
    __device__ __forceinline__ void done(const Unit&) const {}
};

__device__ __forceinline__ unsigned cvt_pk_bf16(float lo, float hi) { unsigned r; asm volatile("v_cvt_pk_bf16_f32 %0, %1, %2" : "=v"(r) : "v"(lo), "v"(hi)); return r; }
typedef float f32x2 __attribute__((ext_vector_type(2)));
__device__ __forceinline__ f32x2 gelu_pk(f32x2 v) {
    const f32x2 av = __builtin_elementwise_abs(v), d = av * 0.2316418882f + 1.0f;
    f32x2 t; t.x = __builtin_amdgcn_rcpf(d.x); t.y = __builtin_amdgcn_rcpf(d.y);
    f32x2 q = t * 0.5307027145f + (-0.7265760135f); q = q * t + 0.7107068705f; q = q * t + (-0.142248368f); q = q * t + 0.127414796f; q = q * t;
    const f32x2 s = (v * v) * (-0.72134752044f);
    f32x2 e; e.x = __builtin_amdgcn_exp2f(s.x); e.y = __builtin_amdgcn_exp2f(s.y);
    const f32x2 m = v * (q * e), r = v - m;
    f32x2 o; o.x = v.x < 0.f ? m.x : r.x; o.y = v.y < 0.f ? m.y : r.y; return o;
}

template <int ACT  > struct EpiBf16 {
    static constexpr bool PERM = true, AFTER_DRAIN = false; static_assert(ACT == 0 || ACT == 1, "EpiBf16: ACT is 0 (none) or 1 (gelu_pk)");
    bf16_t* O; int ldc; const float* bias; int split_cols; size_t split_stride; float scale0;
    __device__ __forceinline__ void operator()(const f32x4 (&acc)[2][2][4][2], const Unit& u, int wr, int wc, int fr, int fq) const {
        const int row0 = u.pm * BM + wr * 64 + fr; int colt = u.pn * BM; bf16_t* base = O;
        float sc = 1.f; if (split_cols) { const int t = colt / split_cols; base += (size_t)t * split_stride; colt -= t * split_cols; if (t == 0) sc = scale0; }
        const int col0 = colt + wc * 32 + 8 * fq, bcol0 = u.pn * BM + wc * 32 + 8 * fq;
        f32x4 bv[2][2];
#pragma unroll
        for (int bj = 0; bj < 2; ++bj)
#pragma unroll
            for (int n = 0; n < 2; ++n) bv[bj][n] = bias ? *(const f32x4*)(bias + bcol0 + bj * HALF + 4 * n) : (f32x4){0.f, 0.f, 0.f, 0.f};
#pragma unroll
        for (int ai = 0; ai < 2; ++ai)
#pragma unroll
            for (int m = 0; m < 4; ++m) { bf16_t* rowp = base + (size_t)(row0 + ai * HALF + m * 16) * ldc + col0;
#pragma unroll
                for (int bj = 0; bj < 2; ++bj) { f32x4 v0 = acc[ai][bj][m][0] + bv[bj][0], v1 = acc[ai][bj][m][1] + bv[bj][1];
                    if (ACT == 1) { f32x2 a = gelu_pk((f32x2){v0[0], v0[1]}), b = gelu_pk((f32x2){v0[2], v0[3]}), c = gelu_pk((f32x2){v1[0], v1[1]}), d = gelu_pk((f32x2){v1[2], v1[3]});
                        v0 = (f32x4){a.x, a.y, b.x, b.y}; v1 = (f32x4){c.x, c.y, d.x, d.y}; }
                    v0 = v0 * sc; v1 = v1 * sc; u32x4 w; w.x = cvt_pk_bf16(v0[0], v0[1]); w.y = cvt_pk_bf16(v0[2], v0[3]); w.z = cvt_pk_bf16(v1[0], v1[1]); w.w = cvt_pk_bf16(v1[2], v1[3]);
                    *(u32x4*)(rowp + bj * HALF) = w; } }
    }
};
template <class Epi, class Sched, bool ALIGN_EPI = false, bool SP2 = false>
__device__ __forceinline__ void gemm_phase(PG8_LAS unsigned char* lds, const Gemm g, const Sched& S, const Epi& E) {
    const int tid = threadIdx.x, wid = __builtin_amdgcn_readfirstlane(tid >> 6), lane = tid & 63, wr = wid >> 2, wc = wid & 3, fr = lane & 15, fq = lane >> 4;
    const int K = g.K, nt = K / BK;
    unsigned voffA[2], voffB[2];
#pragma unroll
    for (int i = 0; i < 2; ++i) { int R, C; stage_rc(tid * 16 + i * 8192, R, C); const int Rb = Epi::PERM ? ((R & ~31) + perm32(R & 31)) : R;
        voffA[i] = (unsigned)(R * K + C) * 2u; voffB[i] = (unsigned)(Rb * K + C) * 2u; }
    const size_t kstep = (size_t)(BK * 2);
    const size_t hstep = (size_t)HALF * K * 2;
    const size_t tstep = 2 * hstep;
    const unsigned ldsw = (unsigned)wid * 1024u;
    const int aoff = lds_byte(wr * 64 + fr, fq * 8), boff = lds_byte(wc * 32 + fr, fq * 8);
#define PG8_SA(b, h) (((b) * 2 + (h)) * HTB)
#define PG8_SB(b, h) ((4 + (b) * 2 + (h)) * HTB)
#define PG8_STAGE(bufoff, gbase, voff) do { _Pragma("unroll") for (int _i = 0; _i < 2; ++_i) \
        __builtin_amdgcn_global_load_lds((const unsigned*)((const char*)(gbase) + (voff)[_i]), (PG8_LAS unsigned*)(lds + (bufoff) + ldsw + _i * 8192), 16, 0, 0); } while (0)
#define PG8_LDA(dst, b, h) do { _Pragma("unroll") for (int m = 0; m < 4; ++m) _Pragma("unroll") for (int k = 0; k < 2; ++k) dst[m][k] = *(const PG8_LAS bf16x8*)(lds + PG8_SA(b, h) + aoff + m * 2048 + k * 1024); } while (0)
#define PG8_LDB(dst, b, h) do { _Pragma("unroll") for (int n = 0; n < 2; ++n) _Pragma("unroll") for (int k = 0; k < 2; ++k) dst[n][k] = *(const PG8_LAS bf16x8*)(lds + PG8_SB(b, h) + boff + n * 2048 + k * 1024); } while (0)
#define PG8_MMA(ai, bj, At, Bt) do { __builtin_amdgcn_s_setprio(1); _Pragma("unroll") for (int m = 0; m < 4; ++m) _Pragma("unroll") for (int n = 0; n < 2; ++n) _Pragma("unroll") for (int k = 0; k < 2; ++k) \
        acc[ai][bj][m][n] = __builtin_amdgcn_mfma_f32_16x16x32_bf16(Bt[n][k], At[m][k], acc[ai][bj][m][n], 0, 0, 0); __builtin_amdgcn_s_setprio(0); } while (0)
#define PG8_WAIT_V(n) asm volatile("s_waitcnt vmcnt(" #n ")" ::: "memory")
#define PG8_WAIT_L(n) asm volatile("s_waitcnt lgkmcnt(" #n ")" ::: "memory")
#define PG8_BAR __builtin_amdgcn_s_barrier()
#define PG8_SCHED __builtin_amdgcn_sched_barrier(0)
    Unit cur, nxt; int ui = 0;
    if (!S.next(0, cur)) return;
    f32x4 acc[2][2][4][2];
#pragma unroll
    for (int a = 0; a < 2; ++a)
#pragma unroll
        for (int b = 0; b < 2; ++b)
#pragma unroll
            for (int m = 0; m < 4; ++m)
#pragma unroll
                for (int n = 0; n < 2; ++n) acc[a][b][m][n] = (f32x4){0.f, 0.f, 0.f, 0.f};
    bf16x8 At[4][2], B0[2][2], B1[2][2];
    const char* cA = (const char*)g.A + (size_t)cur.pm * tstep; const char* cB = (const char*)g.Bt + (size_t)cur.pn * tstep;
    S.a_ready(cur);
    if constexpr (SP2) {
        PG8_STAGE(PG8_SB(0, 0), cB, voffB); PG8_STAGE(PG8_SB(0, 1), cB + hstep, voffB); PG8_STAGE(PG8_SA(0, 0), cA, voffA); PG8_STAGE(PG8_SA(0, 1), cA + hstep, voffA);
        if (wr == 1) PG8_BAR;
        PG8_WAIT_V(2); PG8_BAR;
        PG8_STAGE(PG8_SB(1, 0), cB + kstep, voffB); PG8_STAGE(PG8_SA(1, 0), cA + kstep, voffA); PG8_STAGE(PG8_SB(1, 1), cB + hstep + kstep, voffB);
        PG8_WAIT_V(6); PG8_BAR;
    } else {
        PG8_STAGE(PG8_SB(0, 0), cB, voffB); PG8_STAGE(PG8_SA(0, 0), cA, voffA); PG8_STAGE(PG8_SB(0, 1), cB + hstep, voffB); PG8_STAGE(PG8_SA(0, 1), cA + hstep, voffA);
        if (wr == 1) PG8_BAR;
        PG8_WAIT_V(4); PG8_BAR;
        PG8_STAGE(PG8_SB(1, 0), cB + kstep, voffB); PG8_STAGE(PG8_SA(1, 0), cA + kstep, voffA); PG8_STAGE(PG8_SB(1, 1), cB + hstep + kstep, voffB);
        PG8_WAIT_V(6); PG8_BAR;
    }
    for (;;) {
        const bool has_next = S.next(ui + 1, nxt);
        const char* nA = has_next ? (const char*)g.A + (size_t)nxt.pm * tstep : cA; const char* nB = has_next ? (const char*)g.Bt + (size_t)nxt.pn * tstep : cB;
        for (int t = 0; t < nt; t += 2) {
            const bool last = (t == nt - 2);
            const char* a1 = cA + (size_t)(t + 1) * kstep;
            const char* a2 = last ? nA : cA + (size_t)(t + 2) * kstep; const char* b2 = last ? nB : cB + (size_t)(t + 2) * kstep;
            const char* a3 = a2 + kstep; const char* b3 = b2 + kstep;
            if (last && has_next) S.a_ready(nxt);
            if constexpr (SP2) {
            PG8_LDB(B0, 0, 0); PG8_LDB(B1, 0, 1); PG8_SCHED; PG8_LDA(At, 0, 0); PG8_STAGE(PG8_SA(1, 1), a1 + hstep, voffA);
            PG8_WAIT_V(8); PG8_WAIT_L(0); PG8_BAR; PG8_MMA(0, 0, At, B0); PG8_MMA(0, 1, At, B1); PG8_BAR; PG8_SCHED;
            PG8_LDA(At, 0, 1); PG8_STAGE(PG8_SB(0, 0), b2, voffB); PG8_STAGE(PG8_SB(0, 1), b2 + hstep, voffB); PG8_STAGE(PG8_SA(0, 0), a2, voffA);
            PG8_WAIT_V(8); PG8_WAIT_L(0); PG8_BAR; PG8_MMA(1, 0, At, B0); PG8_MMA(1, 1, At, B1); PG8_BAR; PG8_SCHED;
            PG8_LDB(B0, 1, 0); PG8_LDB(B1, 1, 1); PG8_SCHED; PG8_LDA(At, 1, 0); PG8_STAGE(PG8_SA(0, 1), a2 + hstep, voffA);
            PG8_WAIT_V(8); PG8_WAIT_L(0); PG8_BAR; PG8_MMA(0, 0, At, B0); PG8_MMA(0, 1, At, B1); PG8_BAR; PG8_SCHED;
            PG8_LDA(At, 1, 1); PG8_STAGE(PG8_SB(1, 0), b3, voffB); PG8_STAGE(PG8_SB(1, 1), b3 + hstep, voffB); PG8_STAGE(PG8_SA(1, 0), a3, voffA);
            PG8_WAIT_V(8); PG8_WAIT_L(0); PG8_BAR; PG8_MMA(1, 0, At, B0); PG8_MMA(1, 1, At, B1); PG8_BAR; PG8_SCHED;
            } else {
            PG8_LDB(B0, 0, 0); PG8_SCHED; PG8_LDA(At, 0, 0); PG8_STAGE(PG8_SA(1, 1), a1 + hstep, voffA);
            PG8_WAIT_L(8); PG8_BAR; PG8_WAIT_L(0); PG8_MMA(0, 0, At, B0); PG8_BAR; PG8_SCHED;
            PG8_LDB(B1, 0, 1); PG8_STAGE(PG8_SB(0, 0), b2, voffB);
            PG8_BAR; PG8_WAIT_L(0); PG8_MMA(0, 1, At, B1); PG8_BAR;
            PG8_LDA(At, 0, 1); PG8_STAGE(PG8_SA(0, 0), a2, voffA);
            PG8_BAR; PG8_WAIT_L(0); PG8_MMA(1, 0, At, B0); PG8_BAR; PG8_SCHED;
            PG8_STAGE(PG8_SB(0, 1), b2 + hstep, voffB);
            PG8_WAIT_V(6); PG8_BAR; PG8_MMA(1, 1, At, B1); PG8_BAR;
            PG8_LDB(B0, 1, 0); PG8_SCHED; PG8_LDA(At, 1, 0); PG8_STAGE(PG8_SA(0, 1), a2 + hstep, voffA);
            PG8_WAIT_L(8); PG8_BAR; PG8_WAIT_L(0); PG8_MMA(0, 0, At, B0); PG8_BAR; PG8_SCHED;
            PG8_LDB(B1, 1, 1); PG8_STAGE(PG8_SB(1, 0), b3, voffB);
            PG8_BAR; PG8_WAIT_L(0); PG8_MMA(0, 1, At, B1); PG8_BAR;
            PG8_LDA(At, 1, 1); PG8_STAGE(PG8_SA(1, 0), a3, voffA);
            PG8_BAR; PG8_WAIT_L(0); PG8_MMA(1, 0, At, B0); PG8_BAR; PG8_SCHED;
            PG8_STAGE(PG8_SB(1, 1), b3 + hstep, voffB);
            PG8_WAIT_V(6); PG8_BAR; PG8_MMA(1, 1, At, B1); PG8_BAR;
            }
        }
        if constexpr (ALIGN_EPI) { if (wr == 0) PG8_BAR; }
        if constexpr (!Epi::AFTER_DRAIN) { E(acc, cur, wr, wc, fr, fq); S.done(cur); }
        if (!has_next) break;
#pragma unroll
        for (int a = 0; a < 2; ++a)
#pragma unroll
            for (int b = 0; b < 2; ++b)
#pragma unroll
                for (int m = 0; m < 4; ++m)
#pragma unroll
                    for (int n = 0; n < 2; ++n) acc[a][b][m][n] = (f32x4){0.f, 0.f, 0.f, 0.f};
        cur = nxt; cA = nA; cB = nB; ++ui;
        if constexpr (ALIGN_EPI) { if (wr == 1) PG8_BAR; }
    }
    PG8_WAIT_V(0);
    if constexpr (!ALIGN_EPI) { if (wr == 0) PG8_BAR; }
    PG8_BAR;
    if constexpr (Epi::AFTER_DRAIN) { E.fused(acc, cur, wr, wc, fr, fq, lds, wid, lane); S.done(cur); }
#undef PG8_SA
#undef PG8_SB
#undef PG8_STAGE
#undef PG8_LDA
#undef PG8_LDB
#undef PG8_MMA
#undef PG8_WAIT_V
#undef PG8_WAIT_L
#undef PG8_BAR
#undef PG8_SCHED
}
}
#define GAS __attribute__((address_space(1)))
#define LAS __attribute__((address_space(3)))
typedef unsigned short bf16;
typedef unsigned v4u __attribute__((ext_vector_type(4)));
typedef float f32x4 __attribute__((ext_vector_type(4)));
typedef short bf16x8 __attribute__((ext_vector_type(8)));
typedef GAS unsigned gu32;
typedef GAS unsigned long long gu64;
#define RLX_AGENT __ATOMIC_RELAXED, __HIP_MEMORY_SCOPE_AGENT
#define LDS_WAIT() asm volatile("s_waitcnt lgkmcnt(0)" ::: "memory")
#define VM_WAIT() asm volatile("s_waitcnt vmcnt(0)" ::: "memory")
__device__ __forceinline__ unsigned long long rt() { return __builtin_amdgcn_s_memrealtime(); }
__device__ __forceinline__ unsigned f2bf(float f) { unsigned u = __builtin_bit_cast(unsigned, f); return (u + 0x7fffu + ((u >> 16) & 1u)) >> 16; }
__device__ __forceinline__ unsigned pk2(float lo, float hi) { return f2bf(lo) | (f2bf(hi) << 16); }

#define XB_TMO      128
#define XB_XCNT(j)  (256  + 64 * (j))
#define XB_XSUB(j)  (1280 + 64 * (j))
#define XB_XGEN(j)  (2304 + 64 * (j))
#define XB_TOP      3328
#define XB_TOPGEN   3392
#define XCD_BAR_WORDS 3456
#define XB_SPIN_CAP (1u << 18)

__device__ __forceinline__ unsigned xb_ld(unsigned* p)              { return __hip_atomic_load(p, __ATOMIC_RELAXED, __HIP_MEMORY_SCOPE_AGENT); }
__device__ __forceinline__ unsigned xb_add(unsigned* p, unsigned v) { return __hip_atomic_fetch_add(p, v, __ATOMIC_RELAXED, __HIP_MEMORY_SCOPE_AGENT); }
__device__ __forceinline__ unsigned xb_xcc_id() { return (unsigned)__builtin_amdgcn_s_getreg((3 << 11) | 20) & 0xFu; }
#define XB_SPIN(cond, bar) do { unsigned _sp = 0; while (cond) { __builtin_amdgcn_s_sleep(1); \
    if ((++_sp & 255u) == 0u) { if (xb_ld(&(bar)[XB_TMO])) break; if (_sp > XB_SPIN_CAP) { atomicAdd(&(bar)[XB_TMO], 1u); break; } } } } while (0)

struct XcdBarrier {
    unsigned* bar; unsigned x;
    volatile LAS unsigned* st;
};

__device__ __forceinline__ XcdBarrier xcd_barrier_post(unsigned* bar, volatile LAS unsigned* st) {
    XcdBarrier b; b.bar = bar; b.x = xb_xcc_id(); b.st = st;
    if (threadIdx.x == 0) (void)xb_add(&bar[XB_XCNT(b.x)], 1u);
    return b;
}
__device__ __forceinline__ void xcd_barrier_complete(unsigned* bar, unsigned x, unsigned& nloc, unsigned& nx) {
    const unsigned G = gridDim.x * gridDim.y * gridDim.z;
    unsigned sum, cnt, mine, sp = 0u;
    for (;;) {
        sum = 0u; cnt = 0u; mine = 0u;
#pragma unroll
        for (unsigned j = 0; j < 16; ++j) { const unsigned c = xb_ld(&bar[XB_XCNT(j)]); sum += c; cnt += (c > 0u) ? 1u : 0u; mine = (j == x) ? c : mine; }
        if (sum == G) break;
        __builtin_amdgcn_s_sleep(1);
        if ((++sp & 255u) == 0u) { if (xb_ld(&bar[XB_TMO])) break; if (sp > XB_SPIN_CAP) { atomicAdd(&bar[XB_TMO], 1u); break; } }
    }
    nloc = mine > 0u ? mine : 1u; nx = cnt > 0u ? cnt : 1u;
}

__device__ __forceinline__ void xcd_barrier(const XcdBarrier& b) {
    asm volatile("s_waitcnt vmcnt(0)" ::: "memory");
    __syncthreads();
    if (threadIdx.x == 0) {
        unsigned* bar = b.bar;
        __builtin_amdgcn_s_waitcnt(0);
        unsigned nloc = b.st[0], nx = b.st[1];
        if (nloc == 0u) { xcd_barrier_complete(bar, b.x, nloc, nx); b.st[0] = nloc; b.st[1] = nx; }
        const unsigned old = xb_add(&bar[XB_XSUB(b.x)], 1u);
        const unsigned gen = old / nloc;
        if (old + 1u == (gen + 1u) * nloc) {
            __builtin_amdgcn_fence(__ATOMIC_RELEASE, "agent");
            asm volatile("s_waitcnt vmcnt(0)" ::: "memory");
            const unsigned og = xb_add(&bar[XB_TOP], 1u);
            const unsigned tg = og / nx;
            if (og + 1u == (tg + 1u) * nx) xb_add(&bar[XB_TOPGEN], 1u);
            else XB_SPIN(xb_ld(&bar[XB_TOPGEN]) == tg, bar);
            __builtin_amdgcn_fence(__ATOMIC_ACQUIRE, "agent");
            xb_add(&bar[XB_XGEN(b.x)], 1u);
            asm volatile("s_waitcnt vmcnt(0)" ::: "memory");
        } else {
            XB_SPIN(xb_ld(&bar[XB_XGEN(b.x)]) == gen, bar);
            __builtin_amdgcn_fence(__ATOMIC_ACQUIRE, "agent");
            asm volatile("s_waitcnt vmcnt(0)" ::: "memory");
        }
    }
    __syncthreads();
}

constexpr int NWAVES = 8;
constexpr int D = 1024, FF = 2816, MP = 16384, MS = 512, M = MP + MS;
constexpr int PSH = 1792, PTOT = 3328, OFF_V = 1024, OFF_WD = 1536, OFF_CB = 1792, OFF_CC = 2304, OFF_CH = 2816;
constexpr int NH = 8, DR = 512;
constexpr int NGU = 2 * FF;
constexpr int NLORA = 1536, KLORA = 256;
constexpr float ALPHA = 1.189207115002721f;
constexpr float LN_EPS = 1e-5f, GN_EPS = 64e-5f;
constexpr size_t O_Y = 0, O_WKVP = (size_t)M * D, O_SHP = O_WKVP + 8 * 8 * 4096, O_CVP = O_SHP + 8 * PSH, O_WKVS = O_CVP + 8 * 2 * 512,
                 O_SHS = O_WKVS + (size_t)128 * 8 * 4096, O_CVS = O_SHS + 128 * PSH, O_END = O_CVS + 128 * 2 * 512;
constexpr size_t MiB = 1u << 20;
constexpr size_t WS_CTL = 0, CTL_ZERO_BYTES = 64 * 1024;
constexpr size_t WS_WGU1 = 1 * MiB, WS_WD1 = 12 * MiB, WS_WGU2 = 18 * MiB, WS_WD2 = 29 * MiB, WS_WIN = 35 * MiB, WS_WOUT = 42 * MiB, WS_WL = 44 * MiB;
constexpr size_t WS_XB = 45 * MiB;
constexpr size_t WS_BONUS = 78 * MiB;
constexpr size_t WS_H = 79 * MiB;
constexpr size_t WS_PROJ = 79 * MiB;
constexpr size_t WS_AP = 187 * MiB;
constexpr size_t WS_MIX = 196 * MiB;
constexpr size_t WS_END = 230 * MiB;
constexpr int CW_BAR = 1024;
static_assert((CW_BAR + XCD_BAR_WORDS) * 4 <= (int)CTL_ZERO_BYTES, "ctl");
constexpr int RING_BYTES = 131072, MISC_OFF = 143360, LDS_BYTES = 147456;

__device__ __forceinline__ float bf2f(unsigned short b) { return __builtin_bit_cast(float, (unsigned)b << 16); }
__device__ __forceinline__ float bflo(unsigned w) { return __builtin_bit_cast(float, w << 16); }
__device__ __forceinline__ float bfhi(unsigned w) { return __builtin_bit_cast(float, w & 0xffff0000u); }
__device__ __forceinline__ unsigned pkbf(float lo, float hi) { return pg8::cvt_pk_bf16(lo, hi); }
__device__ __forceinline__ float wave_sum(float v) {
#pragma unroll
    for (int o = 1; o < 64; o <<= 1) v += __shfl_xor(v, o);
    return v;
}
__device__ __forceinline__ float sigmoidf_(float x) { return 1.0f / (1.0f + __expf(-x)); }

struct Args { const float* in[31]; float* out; unsigned char* ws; };
enum { I_XP = 0, I_XS, I_SWKV, I_SSH, I_SCV, I_LN1G, I_LN1B, I_F1G, I_F1U, I_F1D, I_WIN, I_MU, I_W0, I_WLU, I_A0, I_ALU, I_GLU, I_KK, I_KA, I_RK, I_LNXG, I_LNXB, I_CW, I_WOUT,
       I_LN2G, I_LN2B, I_F2G, I_F2U, I_F2D, I_LN3G, I_LN3B };

namespace pg8 {
struct EpiSwiGLU {
    static constexpr bool PERM = true, AFTER_DRAIN = false;
    bf16_t* O; int ldc;
    __device__ __forceinline__ void operator()(const f32x4 (&acc)[2][2][4][2], const Unit& u, int wr, int wc, int fr, int fq) const {
        const int row0 = u.pm * BM + wr * 64 + fr, col0 = u.pn * 128 + wc * 32 + 8 * fq;
#pragma unroll
        for (int ai = 0; ai < 2; ++ai)
#pragma unroll
            for (int m = 0; m < 4; ++m) { bf16_t* rowp = O + (size_t)(row0 + ai * HALF + m * 16) * ldc + col0; float hv[8];
#pragma unroll
                for (int n = 0; n < 2; ++n)
#pragma unroll
                    for (int e = 0; e < 4; ++e) { const float g = acc[ai][0][m][n][e], up = acc[ai][1][m][n][e]; hv[n * 4 + e] = g * __builtin_amdgcn_rcpf(1.0f + __expf(-g)) * up; }
                u32x4 w; w.x = cvt_pk_bf16(hv[0], hv[1]); w.y = cvt_pk_bf16(hv[2], hv[3]); w.z = cvt_pk_bf16(hv[4], hv[5]); w.w = cvt_pk_bf16(hv[6], hv[7]);
                *(u32x4*)rowp = w; }
    }
};
template <bool RES_BF16> struct EpiRes {
    static constexpr bool PERM = false, AFTER_DRAIN = false;
    const void* r0; const void* r1; int split_pm; float* out; int ldc; float alpha, beta;
    __device__ __forceinline__ void operator()(const f32x4 (&acc)[2][2][4][2], const Unit& u, int wr, int wc, int fr, int fq) const {
        const int col0 = u.pn * BM + wc * 32 + 4 * fq;
        const char* rb = (const char*)(u.pm < split_pm ? r0 : r1); const int rrow0 = (u.pm < split_pm ? u.pm : u.pm - split_pm) * BM;
#pragma unroll
        for (int ai = 0; ai < 2; ++ai)
#pragma unroll
            for (int m = 0; m < 4; ++m) { const int rl = ai * HALF + wr * 64 + m * 16 + fr; const size_t off = (size_t)(u.pm * BM + rl) * ldc + col0; const size_t roff = (size_t)(rrow0 + rl) * ldc + col0;
#pragma unroll
                for (int bj = 0; bj < 2; ++bj)
#pragma unroll
                    for (int n = 0; n < 2; ++n) { f32x4 rv;
                        if (RES_BF16) { typedef unsigned u32x2v __attribute__((ext_vector_type(2))); const u32x2v w = *(const u32x2v*)(rb + (roff + bj * HALF + n * 16) * 2);
                            rv = (f32x4){__builtin_bit_cast(float, w.x << 16), __builtin_bit_cast(float, w.x & 0xffff0000u), __builtin_bit_cast(float, w.y << 16), __builtin_bit_cast(float, w.y & 0xffff0000u)}; }
                        else rv = *(const f32x4*)(rb + (roff + bj * HALF + n * 16) * 4);
                        *(f32x4*)(out + off + bj * HALF + n * 16) = rv * alpha + acc[ai][bj][m][n] * beta; } }
    }
};
}

struct Frame {
    LAS unsigned char* lds; int tid, lane, wave, gw, NGW, G;
};

__device__ __forceinline__ void p0_transpose_item(const float* W, int N, bf16* WT, int ldt, int coff, int drow0, LAS float* scr, int k0, int n0, int lane) {
#pragma unroll 8
    for (int i = 0; i < 32; ++i) { const int kk = 2 * i + (lane >> 5); scr[kk * 33 + (lane & 31)] = W[(size_t)(k0 + kk) * N + n0 + (lane & 31)]; }
    LDS_WAIT(); asm volatile("" ::: "memory");
    const int c = lane & 7;
#pragma unroll
    for (int j = 0; j < 4; ++j) { const int n = (lane >> 3) + 8 * j; const LAS float* s = scr + (8 * c) * 33 + n;
        v4u o; o.x = pkbf(s[0 * 33], s[1 * 33]); o.y = pkbf(s[2 * 33], s[3 * 33]); o.z = pkbf(s[4 * 33], s[5 * 33]); o.w = pkbf(s[6 * 33], s[7 * 33]);
        *(GAS v4u*)(WT + (size_t)(drow0 + n) * ldt + coff + k0 + 8 * c) = o; }
    LDS_WAIT(); asm volatile("" ::: "memory");
}

__device__ __forceinline__ void phase_prologue(const Args& A, Frame& F) {
    unsigned char* ws = A.ws;
    LAS float* scr = (LAS float*)(F.lds + F.wave * 16384);
    constexpr int I_GU = 16 * 88, I_DN = 44 * 32, I_IN = 16 * 104, I_OUT = 16 * 32, I_L64 = 16, I_L128 = 32;
    constexpr int NITEMS = 6 * I_GU + I_IN + I_OUT + 2 * I_L64 + I_L128;
    static_assert(I_GU == I_DN, "");
    for (int it = F.gw; it < NITEMS; it += F.NGW) {
        int r = it;
        if (r < 6 * I_GU) { const int mtx = r / I_GU; r -= mtx * I_GU; const int f2 = mtx >= 3, kind = mtx % 3;
            if (kind < 2) { const int nblk = FF / 32, kb = r / nblk, nb = r % nblk, n0 = nb * 32; const int drow = (n0 >> 7) * 256 + (n0 & 127) + kind * 128;
                p0_transpose_item(A.in[(f2 ? I_F2G : I_F1G) + kind], FF, (bf16*)(ws + (f2 ? WS_WGU2 : WS_WGU1)), D, 0, drow, scr, kb * 64, n0, F.lane); }
            else { const int nblk = D / 32, kb = r / nblk, nb = r % nblk;
                p0_transpose_item(A.in[f2 ? I_F2D : I_F1D], D, (bf16*)(ws + (f2 ? WS_WD2 : WS_WD1)), FF, 0, nb * 32, scr, kb * 64, nb * 32, F.lane); }
            continue; }
        r -= 6 * I_GU;
        if (r < I_IN) { const int nblk = PTOT / 32, kb = r / nblk, nb = r % nblk; p0_transpose_item(A.in[I_WIN], PTOT, (bf16*)(ws + WS_WIN), D, 0, nb * 32, scr, kb * 64, nb * 32, F.lane); continue; }
        r -= I_IN;
        if (r < I_OUT) { const int nblk = D / 32, kb = r / nblk, nb = r % nblk; p0_transpose_item(A.in[I_WOUT], D, (bf16*)(ws + WS_WOUT), D, 0, nb * 32, scr, kb * 64, nb * 32, F.lane); continue; }
        r -= I_OUT;
        if (r < I_L64) { p0_transpose_item(A.in[I_WLU], 512, (bf16*)(ws + WS_WL), KLORA, 0, r * 32, scr, 0, r * 32, F.lane); continue; }
        r -= I_L64;
        if (r < I_L64) { p0_transpose_item(A.in[I_ALU], 512, (bf16*)(ws + WS_WL), KLORA, 64, 512 + r * 32, scr, 0, r * 32, F.lane); continue; }
        r -= I_L64;
        { const int kb = r / 16, nb = r % 16; p0_transpose_item(A.in[I_GLU], 512, (bf16*)(ws + WS_WL), KLORA, 128, 1024 + nb * 32, scr, kb * 64, nb * 32, F.lane); }
    }
    { const int gt = F.gw * 64 + F.lane, NT = F.NGW * 64;
      for (int ch = gt; ch < NLORA * KLORA / 8; ch += NT) { const int row = ch >> 5, col = (ch & 31) * 8; const int ty = row >> 9;
          const bool nz = ty == 0 ? (col < 64) : (ty == 1 ? (col >= 64 && col < 128) : (col >= 128));
          if (!nz) *(GAS v4u*)((bf16*)(ws + WS_WL) + (size_t)row * KLORA + col) = (v4u){0u, 0u, 0u, 0u}; } }
    for (int m = F.gw; m < M; m += F.NGW) {
        const float* xrow = m < MP ? A.in[I_XP] + (size_t)m * D : A.in[I_XS] + (size_t)(m - MP) * D;
        const GAS f32x4* xr = (const GAS f32x4*)xrow + F.lane; GAS unsigned long long* o8 = (GAS unsigned long long*)((bf16*)(ws + WS_XB) + (size_t)m * D) + F.lane;
#pragma unroll
        for (int j = 0; j < 4; ++j) { const f32x4 v = xr[64 * j]; o8[64 * j] = (unsigned long long)pkbf(v.x, v.y) | ((unsigned long long)pkbf(v.z, v.w) << 32); }
    }
}

template <bool FINAL> __device__ __forceinline__ void phase_ln(Frame& F, float* z, bf16* xb, const float* g, const float* b) {
    f32x4 gv[4], bv[4];
#pragma unroll
    for (int j = 0; j < 4; ++j) { gv[j] = ((const GAS f32x4*)g)[F.lane + 64 * j]; bv[j] = ((const GAS f32x4*)b)[F.lane + 64 * j]; }
    for (int m = F.gw; m < M; m += F.NGW) {
        GAS f32x4* xr = (GAS f32x4*)(z + (size_t)m * D) + F.lane;
        f32x4 v[4]; float s = 0.f;
#pragma unroll
        for (int j = 0; j < 4; ++j) { v[j] = xr[64 * j]; s += (v[j].x + v[j].y) + (v[j].z + v[j].w); }
        const float mean = wave_sum(s) * (1.f / D); float s2 = 0.f;
#pragma unroll
        for (int j = 0; j < 4; ++j) { v[j] = v[j] - mean; s2 += (v[j].x * v[j].x + v[j].y * v[j].y) + (v[j].z * v[j].z + v[j].w * v[j].w); }
        const float rstd = 1.f / sqrtf(wave_sum(s2) * (1.f / D) + LN_EPS);
        if (FINAL) {
#pragma unroll
            for (int j = 0; j < 4; ++j) xr[64 * j] = v[j] * rstd * gv[j] + bv[j];
        } else {
            GAS unsigned long long* o8 = (GAS unsigned long long*)(xb + (size_t)m * D) + F.lane;
#pragma unroll
            for (int j = 0; j < 4; ++j) { const f32x4 o = v[j] * rstd * gv[j] + bv[j]; o8[64 * j] = (unsigned long long)pkbf(o.x, o.y) | ((unsigned long long)pkbf(o.z, o.w) << 32); }
        }
    }
}

struct Tok { int s, t, T; bool prompt; };
__device__ __forceinline__ Tok tok_of(int n) { Tok k; k.prompt = n < MP; if (k.prompt) { k.s = n >> 11; k.t = n & 2047; k.T = 2048; } else { const int r = n - MP; k.s = r >> 2; k.t = r & 3; k.T = 4; } return k; }

__device__ __forceinline__ void phase_prep(const Args& A, Frame& F) {
    unsigned char* ws = A.ws; const bf16* proj = (const bf16*)(ws + WS_PROJ); bf16* ap = (bf16*)(ws + WS_AP); bf16* mix = (bf16*)(ws + WS_MIX);
    const int lane = F.lane;
    const f32x4 mu4 = *(const GAS f32x4*)(A.in[I_MU] + OFF_WD + 4 * lane);
    float cw[3][8];
#pragma unroll
    for (int i = 0; i < 3; ++i)
#pragma unroll
        for (int e = 0; e < 8; ++e) cw[i][e] = A.in[I_CW][i * 512 + 8 * lane + e];
    typedef unsigned u32x2v __attribute__((ext_vector_type(2)));
    for (int n = F.gw; n < M; n += F.NGW) {
        const Tok k = tok_of(n); const bf16* pr = proj + (size_t)n * PTOT;
        { const u32x2v c = *(const GAS u32x2v*)(pr + OFF_WD + 4 * lane); f32x4 cur = (f32x4){bflo(c.x), bfhi(c.x), bflo(c.y), bfhi(c.y)}, prev;
          if (k.t > 0) { const u32x2v p = *(const GAS u32x2v*)(pr - PTOT + OFF_WD + 4 * lane); prev = (f32x4){bflo(p.x), bfhi(p.x), bflo(p.y), bfhi(p.y)}; }
          else if (!k.prompt) prev = *(const GAS f32x4*)(A.in[I_SSH] + (size_t)k.s * PSH + OFF_WD + 4 * lane);
          else prev = (f32x4){0.f, 0.f, 0.f, 0.f};
          f32x4 m = cur + mu4 * (prev - cur);
          if (lane < 16) { m.x = tanhf(m.x); m.y = tanhf(m.y); m.z = tanhf(m.z); m.w = tanhf(m.w); }
          else if (lane >= 32) { m.x = sigmoidf_(m.x); m.y = sigmoidf_(m.y); m.z = sigmoidf_(m.z); m.w = sigmoidf_(m.w); }
          u32x2v o; o.x = pkbf(m.x, m.y); o.y = pkbf(m.z, m.w); *(GAS u32x2v*)(ap + (size_t)n * KLORA + 4 * lane) = o; }
        { const v4u cbw = *(const GAS v4u*)(pr + OFF_CB + 8 * lane), ccw = *(const GAS v4u*)(pr + OFF_CC + 8 * lane), chw = *(const GAS v4u*)(pr + OFF_CH + 8 * lane);
          float u2[8], u1[8], u0[8], cb[8];
#pragma unroll
          for (int e = 0; e < 4; ++e) { u2[2 * e] = bflo(ccw[e]) * bflo(chw[e]); u2[2 * e + 1] = bfhi(ccw[e]) * bfhi(chw[e]); cb[2 * e] = bflo(cbw[e]); cb[2 * e + 1] = bfhi(cbw[e]); }
          const float* sc = A.in[I_SCV] + (size_t)k.s * 1024 + 8 * lane;
          if (k.t >= 1) { const v4u a = *(const GAS v4u*)(pr - PTOT + OFF_CC + 8 * lane), b = *(const GAS v4u*)(pr - PTOT + OFF_CH + 8 * lane);
#pragma unroll
              for (int e = 0; e < 4; ++e) { u1[2 * e] = bflo(a[e]) * bflo(b[e]); u1[2 * e + 1] = bfhi(a[e]) * bfhi(b[e]); } }
          else {
#pragma unroll
              for (int e = 0; e < 8; ++e) u1[e] = k.prompt ? 0.f : sc[512 + e]; }
          if (k.t >= 2) { const v4u a = *(const GAS v4u*)(pr - 2 * PTOT + OFF_CC + 8 * lane), b = *(const GAS v4u*)(pr - 2 * PTOT + OFF_CH + 8 * lane);
#pragma unroll
              for (int e = 0; e < 4; ++e) { u0[2 * e] = bflo(a[e]) * bflo(b[e]); u0[2 * e + 1] = bfhi(a[e]) * bfhi(b[e]); } }
          else {
#pragma unroll
              for (int e = 0; e < 8; ++e) u0[e] = k.prompt ? 0.f : sc[k.t * 512 + e]; }
          float y[8];
#pragma unroll
          for (int e = 0; e < 8; ++e) y[e] = cb[e] * (cw[0][e] * u0[e] + cw[1][e] * u1[e] + cw[2][e] * u2[e]);
          v4u o; o.x = pkbf(y[0], y[1]); o.y = pkbf(y[2], y[3]); o.z = pkbf(y[4], y[5]); o.w = pkbf(y[6], y[7]);
          *(GAS v4u*)(mix + (size_t)n * D + 512 + 8 * lane) = o;
          if (k.t >= k.T - 2) { float* co = A.out + (k.prompt ? O_CVP : O_CVS) + ((size_t)k.s * 2 + (k.t - (k.T - 2))) * 512 + 8 * lane;
              *(GAS f32x4*)co = (f32x4){u2[0], u2[1], u2[2], u2[3]}; *(GAS f32x4*)(co + 4) = (f32x4){u2[4], u2[5], u2[6], u2[7]}; } }
        if (k.t == k.T - 1) { float* so = A.out + (k.prompt ? O_SHP : O_SHS) + (size_t)k.s * PSH;
#pragma unroll
            for (int i = 0; i < 7; ++i) { const u32x2v c = *(const GAS u32x2v*)(pr + 256 * i + 4 * lane); *(GAS f32x4*)(so + 256 * i + 4 * lane) = (f32x4){bflo(c.x), bfhi(c.x), bflo(c.y), bfhi(c.y)}; } }
    }
}

constexpr int TC = 32, RB_TOK = 320, RB_VT = TC * RB_TOK, VT_LD = 36, RB_FLOATS = RB_VT + 64 * VT_LD;
constexpr int REC_OBUF_OFF = 2 * RB_FLOATS * 4;
static_assert(REC_OBUF_OFF + 4 * TC * 64 * 4 <= MISC_OFF - 320, "recurrence LDS");
__device__ __forceinline__ float row16_allsum(float x) {
    x += __builtin_bit_cast(float, __builtin_amdgcn_update_dpp(0, __builtin_bit_cast(int, x), 0x128, 0xf, 0xf, false));
    x += __builtin_bit_cast(float, __builtin_amdgcn_update_dpp(0, __builtin_bit_cast(int, x), 0x124, 0xf, 0xf, false));
    x += __builtin_bit_cast(float, __builtin_amdgcn_update_dpp(0, __builtin_bit_cast(int, x), 0x122, 0xf, 0xf, false));
    x += __builtin_bit_cast(float, __builtin_amdgcn_update_dpp(0, __builtin_bit_cast(int, x), 0x121, 0xf, 0xf, false));
    return x;
}
struct RecItem { int n0, ntok, s, h, q; bool prompt; };
__device__ __forceinline__ RecItem rec_item(int b, int i) {
    RecItem it;
    if (i < 64) { it.prompt = true; it.s = b >> 5; it.h = (b >> 2) & 7; it.q = b & 3; it.n0 = it.s * 2048 + TC * i; it.ntok = TC; }
    else { const int su = b * 4 + (i - 64); it.prompt = false; it.s = su >> 3; it.h = su & 7; it.q = 0; it.n0 = MP + it.s * 4; it.ntok = 4; }
    return it;
}
struct RecPar { float mur, muk, muv, kkp, kap, rkp, w0p, a0p; };
__device__ __forceinline__ void rec_emit(const RecPar& P, float r, float k, float v, float araw, float wraw, LAS float* buf, int tt, int lane, float* bonus_out) {
    const float a = sigmoidf_(P.a0p + araw), w = __expf(-0.6065306597126334f * sigmoidf_(P.w0p + wraw));
    const float kkr = k * P.kkp; const float ss2 = wave_sum(kkr * kkr); const float kk = kkr / fmaxf(sqrtf(ss2), 1e-12f);
    const float k2 = k * (1.0f + (a - 1.0f) * P.kap), nb = -kk * a;
    const float bon = wave_sum(r * k2 * P.rkp);
    if (bonus_out && lane == 0) *bonus_out = bon;
    LAS float* bt = buf + tt * RB_TOK;
    bt[lane] = r; bt[64 + lane] = w; bt[128 + lane] = k2; bt[192 + lane] = kk; bt[256 + lane] = nb; buf[RB_VT + lane * VT_LD + tt] = v;
}
__device__ __forceinline__ void rec_produce(const Args& A, const RecItem& it, LAS float* buf, int pw, int lane) {
    unsigned char* ws = A.ws; const bf16* proj = (const bf16*)(ws + WS_PROJ);
    const bf16* lora = (const bf16*)A.out;
    float* bonus = (float*)(ws + WS_BONUS);
    const int c = it.h * 64 + lane;
    RecPar P; P.mur = A.in[I_MU][c]; P.muk = A.in[I_MU][512 + c]; P.muv = A.in[I_MU][1024 + c]; P.kkp = A.in[I_KK][c]; P.kap = A.in[I_KA][c]; P.rkp = A.in[I_RK][c]; P.w0p = A.in[I_W0][c]; P.a0p = A.in[I_A0][c];
    if (it.prompt) {
        const int n1 = it.n0 + pw * 8; const bool has_prev = (n1 & 2047) != 0;
        const bf16* pr = proj + (size_t)n1 * PTOT + c; const bf16* lr = lora + (size_t)n1 * NLORA + c;
        unsigned short rr[9], kr[9], vr[9], ar[8], wr_[8];
        rr[0] = 0; kr[0] = 0; vr[0] = 0;
        if (has_prev) { rr[0] = pr[-PTOT]; kr[0] = pr[512 - PTOT]; vr[0] = pr[1024 - PTOT]; }
#pragma unroll
        for (int i = 0; i < 8; ++i) { rr[i + 1] = pr[(size_t)i * PTOT]; kr[i + 1] = pr[(size_t)i * PTOT + 512]; vr[i + 1] = pr[(size_t)i * PTOT + 1024]; wr_[i] = lr[(size_t)i * NLORA]; ar[i] = lr[(size_t)i * NLORA + 512]; }
#pragma unroll
        for (int i = 0; i < 8; ++i) {
            const float rc = bf2f(rr[i + 1]), kc = bf2f(kr[i + 1]), vc = bf2f(vr[i + 1]), rp = bf2f(rr[i]), kp = bf2f(kr[i]), vp = bf2f(vr[i]);
            rec_emit(P, rc + P.mur * (rp - rc), kc + P.muk * (kp - kc), vc + P.muv * (vp - vc), bf2f(ar[i]), bf2f(wr_[i]), buf, pw * 8 + i, lane, it.q == 0 ? bonus + (size_t)(n1 + i) * 8 + it.h : nullptr);
        }
    } else {
        const int tt = pw, n = it.n0 + tt;
        const bf16* pr = proj + (size_t)n * PTOT + c;
        const float rc = bf2f(pr[0]), kc = bf2f(pr[512]), vc = bf2f(pr[1024]);
        float rp, kp, vp;
        if (tt > 0) { rp = bf2f(pr[-PTOT]); kp = bf2f(pr[512 - PTOT]); vp = bf2f(pr[1024 - PTOT]); }
        else { const float* ss = A.in[I_SSH] + (size_t)it.s * PSH + c; rp = ss[0]; kp = ss[512]; vp = ss[1024]; }
        rec_emit(P, rc + P.mur * (rp - rc), kc + P.muk * (kp - kc), vc + P.muv * (vp - vc), bf2f(lora[(size_t)n * NLORA + 512 + c]), bf2f(lora[(size_t)n * NLORA + c]), buf, tt, lane, bonus + (size_t)n * 8 + it.h);
    }
}
typedef float f32x2 __attribute__((ext_vector_type(2)));
struct RV { f32x4 kk, w, nb, k, r; };
__device__ __forceinline__ void rec_load(RV& X, const LAS float* bt, int l) {
    X.kk = *(const LAS f32x4*)(bt + 192 + 4 * l); X.w = *(const LAS f32x4*)(bt + 64 + 4 * l); X.nb = *(const LAS f32x4*)(bt + 256 + 4 * l);
    X.k = *(const LAS f32x4*)(bt + 128 + 4 * l); X.r = *(const LAS f32x4*)(bt + 4 * l);
}
__device__ __forceinline__ float rec_comp(f32x4& S, const RV& X, float vi) {
    f32x2 p = S.xy * X.kk.xy; p = S.zw * X.kk.zw + p; float d_ = row16_allsum(p.x + p.y);
    const f32x4 T_ = S * X.w + X.k * vi; S = T_ + X.nb * d_;
    f32x2 q = S.xy * X.r.xy; q = S.zw * X.r.zw + q; return q.x + q.y;
}
__device__ __forceinline__ void phase_recurrence(const Args& A, Frame& F) {
    LAS float* bufs = (LAS float*)F.lds;
    LAS float* obuf = (LAS float*)(F.lds + REC_OBUF_OFF) + (F.wave & 3) * (TC * 64);
    bf16* mix = (bf16*)(A.ws + WS_MIX);
    const int b = blockIdx.x, lane = F.lane, w = F.wave, l = lane & 15, rg = lane >> 4;
    constexpr int NIT = 68;
    f32x4 S = (f32x4){0.f, 0.f, 0.f, 0.f};
    if (w >= 4) { const RecItem it0 = rec_item(b, 0); rec_produce(A, it0, bufs, w - 4, lane); }
    __syncthreads();
    for (int i = 0; i < NIT; ++i) {
        if (w >= 4) { if (i + 1 < NIT) { const RecItem itn = rec_item(b, i + 1); rec_produce(A, itn, bufs + ((i + 1) & 1) * RB_FLOATS, w - 4, lane); } }
        else {
            __builtin_amdgcn_s_setprio(2);
            const RecItem it = rec_item(b, i); const LAS float* buf = bufs + (i & 1) * RB_FLOATS;
            if (it.prompt) {
                const int irow = it.q * 16 + w * 4 + rg; const LAS float* vrow = buf + RB_VT + irow * VT_LD; float opv[TC];
f32x4 v4[TC / 4];
#pragma unroll
                for (int t4 = 0; t4 < TC / 4; ++t4) v4[t4] = *(const LAS f32x4*)(vrow + 4 * t4);
                RV X[2]; rec_load(X[0], buf, l);
#pragma unroll
                for (int t = 0; t < TC; ++t) {
                    if (t + 1 < TC) rec_load(X[(t + 1) & 1], buf + (t + 1) * RB_TOK, l);
                    __builtin_amdgcn_sched_barrier(0);
                    opv[t] = rec_comp(S, X[t & 1], v4[t >> 2][t & 3]);
                    __builtin_amdgcn_sched_barrier(0);
                }
#pragma unroll
                for (int t = 0; t < TC; ++t) obuf[t * 64 + lane] = opv[t];
                { const int t = lane >> 1, pr2 = lane & 1; const LAS f32x4* p0 = (const LAS f32x4*)(obuf + t * 64 + pr2 * 32);
                  const f32x4 a0 = p0[0], a1 = p0[1], a2 = p0[2], a3 = p0[3], b0 = p0[4], b1 = p0[5], b2 = p0[6], b3 = p0[7];
                  const f32x4 sa = (a0 + a1) + (a2 + a3), sb = (b0 + b1) + (b2 + b3);
                  const float o0 = (sa.x + sa.y) + (sa.z + sa.w), o1 = (sb.x + sb.y) + (sb.z + sb.w);
                  *(GAS unsigned*)(mix + (size_t)(it.n0 + t) * D + it.h * 64 + it.q * 16 + w * 4 + 2 * pr2) = pkbf(o0, o1); }
                if (i == 63) *(GAS f32x4*)(A.out + O_WKVP + ((size_t)(it.s * 8 + it.h) * 64 + irow) * 64 + 4 * l) = S;
            } else {
                f32x4 Sq[4]; float ops[16];
#pragma unroll
                for (int qq = 0; qq < 4; ++qq) Sq[qq] = *(const GAS f32x4*)(A.in[I_SWKV] + ((size_t)(it.s * 8 + it.h) * 64 + qq * 16 + w * 4 + rg) * 64 + 4 * l);
#pragma unroll
                for (int qq = 0; qq < 4; ++qq) { const int irow = qq * 16 + w * 4 + rg; const f32x4 v4 = *(const LAS f32x4*)(buf + RB_VT + irow * VT_LD);
#pragma unroll
                    for (int t = 0; t < 4; ++t) { RV X; rec_load(X, buf + t * RB_TOK, l); ops[t * 4 + qq] = rec_comp(Sq[qq], X, v4[t]); }
                    *(GAS f32x4*)(A.out + O_WKVS + ((size_t)(it.s * 8 + it.h) * 64 + irow) * 64 + 4 * l) = Sq[qq]; }
#pragma unroll
                for (int x = 0; x < 16; ++x) obuf[x * 64 + lane] = ops[x];
                { const int t = lane >> 4, qq = (lane >> 2) & 3, rr = lane & 3; const LAS f32x4* p0 = (const LAS f32x4*)(obuf + (t * 4 + qq) * 64 + rr * 16);
                  const f32x4 sa = (p0[0] + p0[1]) + (p0[2] + p0[3]); const float o = (sa.x + sa.y) + (sa.z + sa.w);
                  mix[(size_t)(it.n0 + t) * D + it.h * 64 + qq * 16 + w * 4 + rr] = (bf16)(pkbf(o, 0.f) & 0xffffu); }
            }
            __builtin_amdgcn_s_setprio(0);
        }
        __syncthreads();
    }
}

__device__ __forceinline__ void phase_post(const Args& A, Frame& F) {
    unsigned char* ws = A.ws; const bf16* proj = (const bf16*)(ws + WS_PROJ); bf16* mix = (bf16*)(ws + WS_MIX);
    const bf16* recg = (const bf16*)A.out + 1024;   const float* bonus = (const float*)(ws + WS_BONUS);
    const int lane = F.lane, c0 = 8 * lane, h = lane >> 3;
    float muv[8], lg[8], lb[8];
#pragma unroll
    for (int e = 0; e < 8; ++e) { muv[e] = A.in[I_MU][OFF_V + c0 + e]; lg[e] = A.in[I_LNXG][c0 + e]; lb[e] = A.in[I_LNXB][c0 + e]; }
    for (int n = F.gw; n < M; n += F.NGW) {
        const Tok k = tok_of(n);
        const v4u ow = *(const GAS v4u*)(mix + (size_t)n * D + c0), gw4 = *(const GAS v4u*)(recg + (size_t)n * NLORA + c0), vcw = *(const GAS v4u*)(proj + (size_t)n * PTOT + OFF_V + c0);
        float o[8], g[8], v[8], vp[8];
#pragma unroll
        for (int e = 0; e < 4; ++e) { o[2 * e] = bflo(ow[e]); o[2 * e + 1] = bfhi(ow[e]); g[2 * e] = bflo(gw4[e]); g[2 * e + 1] = bfhi(gw4[e]); v[2 * e] = bflo(vcw[e]); v[2 * e + 1] = bfhi(vcw[e]); }
        if (k.t > 0) { const v4u pw4 = *(const GAS v4u*)(proj + (size_t)(n - 1) * PTOT + OFF_V + c0);
#pragma unroll
            for (int e = 0; e < 4; ++e) { vp[2 * e] = bflo(pw4[e]); vp[2 * e + 1] = bfhi(pw4[e]); } }
        else {
#pragma unroll
            for (int e = 0; e < 8; ++e) vp[e] = k.prompt ? 0.f : A.in[I_SSH][(size_t)k.s * PSH + OFF_V + c0 + e]; }
        float s = 0.f;
#pragma unroll
        for (int e = 0; e < 8; ++e) s += o[e];
        s += __shfl_xor(s, 1); s += __shfl_xor(s, 2); s += __shfl_xor(s, 4);
        const float mean = s * (1.f / 64.f); float q = 0.f;
#pragma unroll
        for (int e = 0; e < 8; ++e) { o[e] -= mean; q += o[e] * o[e]; }
        q += __shfl_xor(q, 1); q += __shfl_xor(q, 2); q += __shfl_xor(q, 4);
        const float rstd = 1.0f / sqrtf(q * (1.f / 64.f) + GN_EPS); const float bon = bonus[(size_t)n * 8 + h];
        float y[8];
#pragma unroll
        for (int e = 0; e < 8; ++e) { const float vm = v[e] + muv[e] * (vp[e] - v[e]); y[e] = (o[e] * rstd * lg[e] + lb[e] + bon * vm) * g[e]; }
        v4u ov; ov.x = pkbf(y[0], y[1]); ov.y = pkbf(y[2], y[3]); ov.z = pkbf(y[4], y[5]); ov.w = pkbf(y[6], y[7]);
        *(GAS v4u*)(mix + (size_t)n * D + c0) = ov;
    }
}

__global__ void __launch_bounds__(NWAVES * 64, 2) mk_fwd(Args A) {
    extern __shared__ __attribute__((aligned(16))) unsigned char lds_raw[];
    Frame F; F.lds = (LAS unsigned char*)lds_raw; F.tid = threadIdx.x; F.lane = F.tid & 63; F.wave = __builtin_amdgcn_readfirstlane(F.tid >> 6);
    F.G = gridDim.x; F.gw = blockIdx.x * NWAVES + F.wave; F.NGW = F.G * NWAVES;
    volatile LAS unsigned* MISC = (volatile LAS unsigned*)(F.lds + MISC_OFF);
    for (int u = F.tid; u < (LDS_BYTES - MISC_OFF) / 4; u += NWAVES * 64) ((LAS unsigned*)(F.lds + MISC_OFF))[u] = 0u;
    __syncthreads();
    unsigned char* ws = A.ws;
    XcdBarrier bar = xcd_barrier_post((unsigned*)(ws + WS_CTL) + CW_BAR, MISC + 8);
#define GRID_BAR() xcd_barrier(bar)
    bf16* XB = (bf16*)(ws + WS_XB); bf16* HB = (bf16*)(ws + WS_H); bf16* PROJ = (bf16*)(ws + WS_PROJ); bf16* AP = (bf16*)(ws + WS_AP); bf16* MIX = (bf16*)(ws + WS_MIX);
    float* Z = A.out + O_Y;
    LAS unsigned char* ring = F.lds;

#ifndef PHMASK
#define PHMASK 0xFFFF
#endif
#if (PHMASK >> 0) & 1
    phase_prologue(A, F); GRID_BAR();
#endif
#if (PHMASK >> 1) & 1
    { pg8::Gemm g{XB, (const bf16*)(ws + WS_WGU1), M, NGU, D}; pg8::StaticOrder S; S.init(M, NGU, F.G, (int)blockIdx.x); pg8::EpiSwiGLU E{HB, FF};
      pg8::gemm_phase<pg8::EpiSwiGLU, pg8::StaticOrder, true, true>(ring, g, S, E); }
#endif
    GRID_BAR();
#if (PHMASK >> 2) & 1
    { pg8::Gemm g{HB, (const bf16*)(ws + WS_WD1), M, D, FF}; pg8::StaticOrder S; S.init(M, D, F.G, (int)blockIdx.x); pg8::EpiRes<false> E{A.in[I_XP], A.in[I_XS], MP / 256, Z, D, ALPHA, 0.5f};
      pg8::gemm_phase<pg8::EpiRes<false>, pg8::StaticOrder, true, true>(ring, g, S, E); }
#endif
    GRID_BAR();
#if (PHMASK >> 3) & 1
    phase_ln<false>(F, Z, XB, A.in[I_LN1G], A.in[I_LN1B]); GRID_BAR();
#endif
#if (PHMASK >> 4) & 1
    { pg8::Gemm g{XB, (const bf16*)(ws + WS_WIN), M, PTOT, D}; pg8::StaticOrder S; S.init(M, PTOT, F.G, (int)blockIdx.x); pg8::EpiBf16<0> E{PROJ, PTOT, nullptr, 0, 0, 1.f};
      pg8::gemm_phase<pg8::EpiBf16<0>, pg8::StaticOrder, true, true>(ring, g, S, E); }
#endif
    GRID_BAR();
#if (PHMASK >> 5) & 1
    phase_prep(A, F); GRID_BAR();
#endif
#if (PHMASK >> 6) & 1
    { pg8::Gemm g{AP, (const bf16*)(ws + WS_WL), M, NLORA, KLORA}; pg8::StaticOrder S; S.init(M, NLORA, F.G, (int)blockIdx.x);
      pg8::EpiBf16<0> E{(bf16*)A.out, NLORA, nullptr, 0, 0, 1.f};
      pg8::gemm_phase<pg8::EpiBf16<0>, pg8::StaticOrder, true, true>(ring, g, S, E); }
#endif
    GRID_BAR();
#if (PHMASK >> 7) & 1
    phase_recurrence(A, F); GRID_BAR();
#endif
#if (PHMASK >> 8) & 1
    phase_post(A, F); GRID_BAR();
#endif
#if (PHMASK >> 9) & 1
    { pg8::Gemm g{MIX, (const bf16*)(ws + WS_WOUT), M, D, D}; pg8::StaticOrder S; S.init(M, D, F.G, (int)blockIdx.x); pg8::EpiRes<true> E{XB, XB, 1 << 30, Z, D, ALPHA, 1.0f};
      pg8::gemm_phase<pg8::EpiRes<true>, pg8::StaticOrder, true, true>(ring, g, S, E); }
#endif
    GRID_BAR();
#if (PHMASK >> 10) & 1
    phase_ln<false>(F, Z, XB, A.in[I_LN2G], A.in[I_LN2B]); GRID_BAR();
#endif
#if (PHMASK >> 11) & 1
    { pg8::Gemm g{XB, (const bf16*)(ws + WS_WGU2), M, NGU, D}; pg8::StaticOrder S; S.init(M, NGU, F.G, (int)blockIdx.x); pg8::EpiSwiGLU E{HB, FF};
      pg8::gemm_phase<pg8::EpiSwiGLU, pg8::StaticOrder, true, true>(ring, g, S, E); }
#endif
    GRID_BAR();
#if (PHMASK >> 12) & 1
    { pg8::Gemm g{HB, (const bf16*)(ws + WS_WD2), M, D, FF}; pg8::StaticOrder S; S.init(M, D, F.G, (int)blockIdx.x); pg8::EpiRes<true> E{XB, XB, 1 << 30, Z, D, ALPHA, 0.5f};
      pg8::gemm_phase<pg8::EpiRes<true>, pg8::StaticOrder, true, true>(ring, g, S, E); }
#endif
    GRID_BAR();
#if (PHMASK >> 13) & 1
    phase_ln<true>(F, Z, XB, A.in[I_LN3G], A.in[I_LN3B]);
#endif
}

extern "C" void kernel_launch(void* const* d_in, const int* in_sizes, int n_in, void* d_out, int out_size, void* d_ws, size_t ws_size, hipStream_t stream) {
    static int grid = 0;
    if (grid == 0) {
        if (n_in != 31 || out_size != (int)O_END || ws_size < WS_END) { fprintf(stderr, "kernel_launch: unexpected sizes n_in %d out %d ws %zu\n", n_in, out_size, ws_size); grid = -1; return; }
        int dev = 0, cus = 0, per_cu = 0;
        if (hipGetDevice(&dev) != hipSuccess || hipDeviceGetAttribute(&cus, hipDeviceAttributeMultiprocessorCount, dev) != hipSuccess) { grid = -1; return; }
        if (hipFuncSetAttribute((const void*)mk_fwd, hipFuncAttributeMaxDynamicSharedMemorySize, LDS_BYTES) != hipSuccess) { fprintf(stderr, "kernel_launch: hipFuncSetAttribute failed\n"); grid = -1; return; }
        if (hipOccupancyMaxActiveBlocksPerMultiprocessor(&per_cu, (const void*)mk_fwd, NWAVES * 64, LDS_BYTES) != hipSuccess || per_cu < 1) { fprintf(stderr, "kernel_launch: occupancy query says %d\n", per_cu); (void)hipGetLastError(); grid = -1; return; }
        if (cus != 256) { fprintf(stderr, "kernel_launch: built for 256 CUs, found %d\n", cus); grid = -1; return; }
        grid = 256;
    }
    if (grid < 0) return;
    (void)hipMemsetAsync((char*)d_ws + WS_CTL, 0, CTL_ZERO_BYTES, stream);
    Args a{};
    for (int i = 0; i < 31; ++i) a.in[i] = (const float*)d_in[i];
    a.out = (float*)d_out; a.ws = (unsigned char*)d_ws;
    hipLaunchKernelGGL(mk_fwd, dim3(grid), dim3(NWAVES * 64), LDS_BYTES, stream, a);
}
```

```cpp
#include <hip/hip_runtime.h>
#include <cstdio>
#include <cstdint>
namespace pg8 {
#define PG8_LAS __attribute__((address_space(3)))
typedef unsigned short bf16_t;
typedef short bf16x8 __attribute__((ext_vector_type(8)));
typedef float f32x4 __attribute__((ext_vector_type(4)));
typedef unsigned u32x4 __attribute__((ext_vector_type(4)));
constexpr int BM = 256, BK = 64, HALF = 128, HTB = HALF * BK * 2  , STAGE_BYTES = 8 * HTB, NXCD = 8, WGM = 8;

__host__ __device__ __forceinline__ int lds_byte(int r, int c) { const int st = (r >> 4) * 2 + (c >> 5), rr = r & 15, cc = c & 31, ob = rr * 64 + cc * 2; return st * 1024 + (ob ^ (((ob >> 9) & 1) << 5)); }
__host__ __device__ __forceinline__ void stage_rc(int b, int& R, int& C) { const int st = b / 1024, sb = b % 1024, swz = sb ^ (((sb >> 9) & 1) << 5); R = (st >> 1) * 16 + swz / 64; C = (st & 1) * 32 + (swz % 64) / 2; }
__host__ __device__ __forceinline__ int perm32(int rho) { const int n = rho >> 4, i = rho & 15; return 8 * (i >> 2) + 4 * n + (i & 3); }

struct Unit { int pm, pn; };
struct Gemm { const bf16_t* A; const bf16_t* Bt; int M, N, K; };

struct StaticOrder {
    int nM, nN, nwg, G, c;
    __host__ __device__ void init(int M, int N, int G_, int c_) { nM = M / BM; nN = N / BM; nwg = nM * nN; G = G_; c = c_; }
    __host__ __device__ bool next(int i, Unit& u) const {
        const long L = (long)i * G + c; if (L >= nwg) return false;
        int wgid = (int)L; { const int q = nwg / NXCD, r = nwg % NXCD, xcd = wgid % NXCD, off = wgid / NXCD; wgid = (xcd < r ? xcd * (q + 1) : r * (q + 1) + (xcd - r) * q) + off; }
        const int nig = WGM * nN, gid = wgid / nig, fm = gid * WGM, gsz = (nM - fm) < WGM ? (nM - fm) : WGM;
        u.pm = fm + ((wgid % nig) % gsz); u.pn = (wgid % nig) / gsz; return true;
    }
    __device__ __forceinline__ void a_ready(const Unit&) const {}
    __device__ __forceinline__ void done(const Unit&) const {}
};

__device__ __forceinline__ unsigned cvt_pk_bf16(float lo, float hi) { unsigned r; asm volatile("v_cvt_pk_bf16_f32 %0, %1, %2" : "=v"(r) : "v"(lo), "v"(hi)); return r; }
typedef float f32x2 __attribute__((ext_vector_type(2)));
__device__ __forceinline__ f32x2 gelu_pk(f32x2 v) {
    const f32x2 av = __builtin_elementwise_abs(v), d = av * 0.2316418882f + 1.0f;
    f32x2 t; t.x = __builtin_amdgcn_rcpf(d.x); t.y = __builtin_amdgcn_rcpf(d.y);
    f32x2 q = t * 0.5307027145f + (-0.7265760135f); q = q * t + 0.7107068705f; q = q * t + (-0.142248368f); q = q * t + 0.127414796f; q = q * t;
    const f32x2 s = (v * v) * (-0.72134752044f);
    f32x2 e; e.x = __builtin_amdgcn_exp2f(s.x); e.y = __builtin_amdgcn_exp2f(s.y);
    const f32x2 m = v * (q * e), r = v - m;
    f32x2 o; o.x = v.x < 0.f ? m.x : r.x; o.y = v.y < 0.f ? m.y : r.y; return o;
}

template <int ACT  > struct EpiBf16 {
    static constexpr bool PERM = true, AFTER_DRAIN = false; static_assert(ACT == 0 || ACT == 1, "EpiBf16: ACT is 0 (none) or 1 (gelu_pk)");
    bf16_t* O; int ldc; const float* bias; int split_cols; size_t split_stride; float scale0;
    __device__ __forceinline__ void operator()(const f32x4 (&acc)[2][2][4][2], const Unit& u, int wr, int wc, int fr, int fq) const {
        const int row0 = u.pm * BM + wr * 64 + fr; int colt = u.pn * BM; bf16_t* base = O;
        float sc = 1.f; if (split_cols) { const int t = colt / split_cols; base += (size_t)t * split_stride; colt -= t * split_cols; if (t == 0) sc = scale0; }
        const int col0 = colt + wc * 32 + 8 * fq, bcol0 = u.pn * BM + wc * 32 + 8 * fq;
        f32x4 bv[2][2];
#pragma unroll
        for (int bj = 0; bj < 2; ++bj)
#pragma unroll
            for (int n = 0; n < 2; ++n) bv[bj][n] = bias ? *(const f32x4*)(bias + bcol0 + bj * HALF + 4 * n) : (f32x4){0.f, 0.f, 0.f, 0.f};
#pragma unroll
        for (int ai = 0; ai < 2; ++ai)
#pragma unroll
            for (int m = 0; m < 4; ++m) { bf16_t* rowp = base + (size_t)(row0 + ai * HALF + m * 16) * ldc + col0;
#pragma unroll
                for (int bj = 0; bj < 2; ++bj) { f32x4 v0 = acc[ai][bj][m][0] + bv[bj][0], v1 = acc[ai][bj][m][1] + bv[bj][1];
                    if (ACT == 1) { f32x2 a = gelu_pk((f32x2){v0[0], v0[1]}), b = gelu_pk((f32x2){v0[2], v0[3]}), c = gelu_pk((f32x2){v1[0], v1[1]}), d = gelu_pk((f32x2){v1[2], v1[3]});
                        v0 = (f32x4){a.x, a.y, b.x, b.y}; v1 = (f32x4){c.x, c.y, d.x, d.y}; }
                    v0 = v0 * sc; v1 = v1 * sc; u32x4 w; w.x = cvt_pk_bf16(v0[0], v0[1]); w.y = cvt_pk_bf16(v0[2], v0[3]); w.z = cvt_pk_bf16(v1[0], v1[1]); w.w = cvt_pk_bf16(v1[2], v1[3]);
                    *(u32x4*)(rowp + bj * HALF) = w; } }
    }
};
template <class Epi, class Sched, bool ALIGN_EPI = false, bool SP2 = false>
__device__ __forceinline__ void gemm_phase(PG8_LAS unsigned char* lds, const Gemm g, const Sched& S, const Epi& E) {
    const int tid = threadIdx.x, wid = __builtin_amdgcn_readfirstlane(tid >> 6), lane = tid & 63, wr = wid >> 2, wc = wid & 3, fr = lane & 15, fq = lane >> 4;
    const int K = g.K, nt = K / BK;
    unsigned voffA[2], voffB[2];
#pragma unroll
    for (int i = 0; i < 2; ++i) { int R, C; stage_rc(tid * 16 + i * 8192, R, C); const int Rb = Epi::PERM ? ((R & ~31) + perm32(R & 31)) : R;
        voffA[i] = (unsigned)(R * K + C) * 2u; voffB[i] = (unsigned)(Rb * K + C) * 2u; }
    const size_t kstep = (size_t)(BK * 2);
    const size_t hstep = (size_t)HALF * K * 2;
    const size_t tstep = 2 * hstep;
    const unsigned ldsw = (unsigned)wid * 1024u;
    const int aoff = lds_byte(wr * 64 + fr, fq * 8), boff = lds_byte(wc * 32 + fr, fq * 8);
#define PG8_SA(b, h) (((b) * 2 + (h)) * HTB)
#define PG8_SB(b, h) ((4 + (b) * 2 + (h)) * HTB)
#define PG8_STAGE(bufoff, gbase, voff) do { _Pragma("unroll") for (int _i = 0; _i < 2; ++_i) \
        __builtin_amdgcn_global_load_lds((const unsigned*)((const char*)(gbase) + (voff)[_i]), (PG8_LAS unsigned*)(lds + (bufoff) + ldsw + _i * 8192), 16, 0, 0); } while (0)
#define PG8_LDA(dst, b, h) do { _Pragma("unroll") for (int m = 0; m < 4; ++m) _Pragma("unroll") for (int k = 0; k < 2; ++k) dst[m][k] = *(const PG8_LAS bf16x8*)(lds + PG8_SA(b, h) + aoff + m * 2048 + k * 1024); } while (0)
#define PG8_LDB(dst, b, h) do { _Pragma("unroll") for (int n = 0; n < 2; ++n) _Pragma("unroll") for (int k = 0; k < 2; ++k) dst[n][k] = *(const PG8_LAS bf16x8*)(lds + PG8_SB(b, h) + boff + n * 2048 + k * 1024); } while (0)
#define PG8_MMA(ai, bj, At, Bt) do { __builtin_amdgcn_s_setprio(1); _Pragma("unroll") for (int m = 0; m < 4; ++m) _Pragma("unroll") for (int n = 0; n < 2; ++n) _Pragma("unroll") for (int k = 0; k < 2; ++k) \
        acc[ai][bj][m][n] = __builtin_amdgcn_mfma_f32_16x16x32_bf16(Bt[n][k], At[m][k], acc[ai][bj][m][n], 0, 0, 0); __builtin_amdgcn_s_setprio(0); } while (0)
#define PG8_WAIT_V(n) asm volatile("s_waitcnt vmcnt(" #n ")" ::: "memory")
#define PG8_WAIT_L(n) asm volatile("s_waitcnt lgkmcnt(" #n ")" ::: "memory")
#define PG8_BAR __builtin_amdgcn_s_barrier()
#define PG8_SCHED __builtin_amdgcn_sched_barrier(0)
    Unit cur, nxt; int ui = 0;
    if (!S.next(0, cur)) return;
    f32x4 acc[2][2][4][2];
#pragma unroll
    for (int a = 0; a < 2; ++a)
#pragma unroll
        for (int b = 0; b < 2; ++b)
#pragma unroll
            for (int m = 0; m < 4; ++m)
#pragma unroll
                for (int n = 0; n < 2; ++n) acc[a][b][m][n] = (f32x4){0.f, 0.f, 0.f, 0.f};
    bf16x8 At[4][2], B0[2][2], B1[2][2];
    const char* cA = (const char*)g.A + (size_t)cur.pm * tstep; const char* cB = (const char*)g.Bt + (size_t)cur.pn * tstep;
    S.a_ready(cur);
    if constexpr (SP2) {
        PG8_STAGE(PG8_SB(0, 0), cB, voffB); PG8_STAGE(PG8_SB(0, 1), cB + hstep, voffB); PG8_STAGE(PG8_SA(0, 0), cA, voffA); PG8_STAGE(PG8_SA(0, 1), cA + hstep, voffA);
        if (wr == 1) PG8_BAR;
        PG8_WAIT_V(2); PG8_BAR;
        PG8_STAGE(PG8_SB(1, 0), cB + kstep, voffB); PG8_STAGE(PG8_SA(1, 0), cA + kstep, voffA); PG8_STAGE(PG8_SB(1, 1), cB + hstep + kstep, voffB);
        PG8_WAIT_V(6); PG8_BAR;
    } else {
        PG8_STAGE(PG8_SB(0, 0), cB, voffB); PG8_STAGE(PG8_SA(0, 0), cA, voffA); PG8_STAGE(PG8_SB(0, 1), cB + hstep, voffB); PG8_STAGE(PG8_SA(0, 1), cA + hstep, voffA);
        if (wr == 1) PG8_BAR;
        PG8_WAIT_V(4); PG8_BAR;
        PG8_STAGE(PG8_SB(1, 0), cB + kstep, voffB); PG8_STAGE(PG8_SA(1, 0), cA + kstep, voffA); PG8_STAGE(PG8_SB(1, 1), cB + hstep + kstep, voffB);
        PG8_WAIT_V(6); PG8_BAR;
    }
    for (;;) {
        const bool has_next = S.next(ui + 1, nxt);
        const char* nA = has_next ? (const char*)g.A + (size_t)nxt.pm * tstep : cA; const char* nB = has_next ? (const char*)g.Bt + (size_t)nxt.pn * tstep : cB;
        for (int t = 0; t < nt; t += 2) {
            const bool last = (t == nt - 2);
            const char* a1 = cA + (size_t)(t + 1) * kstep;
            const char* a2 = last ? nA : cA + (size_t)(t + 2) * kstep; const char* b2 = last ? nB : cB + (size_t)(t + 2) * kstep;
            const char* a3 = a2 + kstep; const char* b3 = b2 + kstep;
            if (last && has_next) S.a_ready(nxt);
            if constexpr (SP2) {
            PG8_LDB(B0, 0, 0); PG8_LDB(B1, 0, 1); PG8_SCHED; PG8_LDA(At, 0, 0); PG8_STAGE(PG8_SA(1, 1), a1 + hstep, voffA);
            PG8_WAIT_V(8); PG8_WAIT_L(0); PG8_BAR; PG8_MMA(0, 0, At, B0); PG8_MMA(0, 1, At, B1); PG8_BAR; PG8_SCHED;
            PG8_LDA(At, 0, 1); PG8_STAGE(PG8_SB(0, 0), b2, voffB); PG8_STAGE(PG8_SB(0, 1), b2 + hstep, voffB); PG8_STAGE(PG8_SA(0, 0), a2, voffA);
            PG8_WAIT_V(8); PG8_WAIT_L(0); PG8_BAR; PG8_MMA(1, 0, At, B0); PG8_MMA(1, 1, At, B1); PG8_BAR; PG8_SCHED;
            PG8_LDB(B0, 1, 0); PG8_LDB(B1, 1, 1); PG8_SCHED; PG8_LDA(At, 1, 0); PG8_STAGE(PG8_SA(0, 1), a2 + hstep, voffA);
            PG8_WAIT_V(8); PG8_WAIT_L(0); PG8_BAR; PG8_MMA(0, 0, At, B0); PG8_MMA(0, 1, At, B1); PG8_BAR; PG8_SCHED;
            PG8_LDA(At, 1, 1); PG8_STAGE(PG8_SB(1, 0), b3, voffB); PG8_STAGE(PG8_SB(1, 1), b3 + hstep, voffB); PG8_STAGE(PG8_SA(1, 0), a3, voffA);
            PG8_WAIT_V(8); PG8_WAIT_L(0); PG8_BAR; PG8_MMA(1, 0, At, B0); PG8_MMA(1, 1, At, B1); PG8_BAR; PG8_SCHED;
            } else {
            PG8_LDB(B0, 0, 0); PG8_SCHED; PG8_LDA(At, 0, 0); PG8_STAGE(PG8_SA(1, 1), a1 + hstep, voffA);
            PG8_WAIT_L(8); PG8_BAR; PG8_WAIT_L(0); PG8_MMA(0, 0, At, B0); PG8_BAR; PG8_SCHED;
            PG8_LDB(B1, 0, 1); PG8_STAGE(PG8_SB(0, 0), b2, voffB);
            PG8_BAR; PG8_WAIT_L(0); PG8_MMA(0, 1, At, B1); PG8_BAR;
            PG8_LDA(At, 0, 1); PG8_STAGE(PG8_SA(0, 0), a2, voffA);
            PG8_BAR; PG8_WAIT_L(0); PG8_MMA(1, 0, At, B0); PG8_BAR; PG8_SCHED;
            PG8_STAGE(PG8_SB(0, 1), b2 + hstep, voffB);
            PG8_WAIT_V(6); PG8_BAR; PG8_MMA(1, 1, At, B1); PG8_BAR;
            PG8_LDB(B0, 1, 0); PG8_SCHED; PG8_LDA(At, 1, 0); PG8_STAGE(PG8_SA(0, 1), a2 + hstep, voffA);
            PG8_WAIT_L(8); PG8_BAR; PG8_WAIT_L(0); PG8_MMA(0, 0, At, B0); PG8_BAR; PG8_SCHED;
            PG8_LDB(B1, 1, 1); PG8_STAGE(PG8_SB(1, 0), b3, voffB);
            PG8_BAR; PG8_WAIT_L(0); PG8_MMA(0, 1, At, B1); PG8_BAR;
            PG8_LDA(At, 1, 1); PG8_STAGE(PG8_SA(1, 0), a3, voffA);
            PG8_BAR; PG8_WAIT_L(0); PG8_MMA(1, 0, At, B0); PG8_BAR; PG8_SCHED;
            PG8_STAGE(PG8_SB(1, 1), b3 + hstep, voffB);
            PG8_WAIT_V(6); PG8_BAR; PG8_MMA(1, 1, At, B1); PG8_BAR;
            }
        }
        if constexpr (ALIGN_EPI) { if (wr == 0) PG8_BAR; }
        if constexpr (!Epi::AFTER_DRAIN) { E(acc, cur, wr, wc, fr, fq); S.done(cur); }
        if (!has_next) break;
#pragma unroll
        for (int a = 0; a < 2; ++a)
#pragma unroll
            for (int b = 0; b < 2; ++b)
#pragma unroll
                for (int m = 0; m < 4; ++m)
#pragma unroll
                    for (int n = 0; n < 2; ++n) acc[a][b][m][n] = (f32x4){0.f, 0.f, 0.f, 0.f};
        cur = nxt; cA = nA; cB = nB; ++ui;
        if constexpr (ALIGN_EPI) { if (wr == 1) PG8_BAR; }
    }
    PG8_WAIT_V(0);
    if constexpr (!ALIGN_EPI) { if (wr == 0) PG8_BAR; }
    PG8_BAR;
    if constexpr (Epi::AFTER_DRAIN) { E.fused(acc, cur, wr, wc, fr, fq, lds, wid, lane); S.done(cur); }
#undef PG8_SA
#undef PG8_SB
#undef PG8_STAGE
#undef PG8_LDA
#undef PG8_LDB
#undef PG8_MMA
#undef PG8_WAIT_V
#undef PG8_WAIT_L
#undef PG8_BAR
#undef PG8_SCHED
}
}
#define GAS __attribute__((address_space(1)))
#define LAS __attribute__((address_space(3)))
typedef unsigned short bf16;
typedef unsigned v4u __attribute__((ext_vector_type(4)));
typedef float f32x4 __attribute__((ext_vector_type(4)));
typedef short bf16x8 __attribute__((ext_vector_type(8)));
typedef GAS unsigned gu32;
typedef GAS unsigned long long gu64;
#define RLX_AGENT __ATOMIC_RELAXED, __HIP_MEMORY_SCOPE_AGENT
#define LDS_WAIT() asm volatile("s_waitcnt lgkmcnt(0)" ::: "memory")
#define VM_WAIT() asm volatile("s_waitcnt vmcnt(0)" ::: "memory")
__device__ __forceinline__ unsigned long long rt() { return __builtin_amdgcn_s_memrealtime(); }
__device__ __forceinline__ unsigned f2bf(float f) { unsigned u = __builtin_bit_cast(unsigned, f); return (u + 0x7fffu + ((u >> 16) & 1u)) >> 16; }
__device__ __forceinline__ unsigned pk2(float lo, float hi) { return f2bf(lo) | (f2bf(hi) << 16); }

#define XB_TMO      128
#define XB_XCNT(j)  (256  + 64 * (j))
#define XB_XSUB(j)  (1280 + 64 * (j))
#define XB_XGEN(j)  (2304 + 64 * (j))
#define XB_TOP      3328
#define XB_TOPGEN   3392
#define XCD_BAR_WORDS 3456
#define XB_SPIN_CAP (1u << 18)

__device__ __forceinline__ unsigned xb_ld(unsigned* p)              { return __hip_atomic_load(p, __ATOMIC_RELAXED, __HIP_MEMORY_SCOPE_AGENT); }
__device__ __forceinline__ unsigned xb_add(unsigned* p, unsigned v) { return __hip_atomic_fetch_add(p, v, __ATOMIC_RELAXED, __HIP_MEMORY_SCOPE_AGENT); }
__device__ __forceinline__ unsigned xb_xcc_id() { return (unsigned)__builtin_amdgcn_s_getreg((3 << 11) | 20) & 0xFu; }
#define XB_SPIN(cond, bar) do { unsigned _sp = 0; while (cond) { __builtin_amdgcn_s_sleep(1); \
    if ((++_sp & 255u) == 0u) { if (xb_ld(&(bar)[XB_TMO])) break; if (_sp > XB_SPIN_CAP) { atomicAdd(&(bar)[XB_TMO], 1u); break; } } } } while (0)

struct XcdBarrier {
    unsigned* bar; unsigned x;
    volatile LAS unsigned* st;
};

__device__ __forceinline__ XcdBarrier xcd_barrier_post(unsigned* bar, volatile LAS unsigned* st) {
    XcdBarrier b; b.bar = bar; b.x = xb_xcc_id(); b.st = st;
    if (threadIdx.x == 0) (void)xb_add(&bar[XB_XCNT(b.x)], 1u);
    return b;
}
__device__ __forceinline__ void xcd_barrier_complete(unsigned* bar, unsigned x, unsigned& nloc, unsigned& nx) {
    const unsigned G = gridDim.x * gridDim.y * gridDim.z;
    unsigned sum, cnt, mine, sp = 0u;
    for (;;) {
        sum = 0u; cnt = 0u; mine = 0u;
#pragma unroll
        for (unsigned j = 0; j < 16; ++j) { const unsigned c = xb_ld(&bar[XB_XCNT(j)]); sum += c; cnt += (c > 0u) ? 1u : 0u; mine = (j == x) ? c : mine; }
        if (sum == G) break;
        __builtin_amdgcn_s_sleep(1);
        if ((++sp & 255u) == 0u) { if (xb_ld(&bar[XB_TMO])) break; if (sp > XB_SPIN_CAP) { atomicAdd(&bar[XB_TMO], 1u); break; } }
    }
    nloc = mine > 0u ? mine : 1u; nx = cnt > 0u ? cnt : 1u;
}

__device__ __forceinline__ void xcd_barrier(const XcdBarrier& b) {
    asm volatile("s_waitcnt vmcnt(0)" ::: "memory");
    __syncthreads();
    if (threadIdx.x == 0) {
        unsigned* bar = b.bar;
        __builtin_amdgcn_s_waitcnt(0);
        unsigned nloc = b.st[0], nx = b.st[1];
        if (nloc == 0u) { xcd_barrier_complete(bar, b.x, nloc, nx); b.st[0] = nloc; b.st[1] = nx; }
        const unsigned old = xb_add(&bar[XB_XSUB(b.x)], 1u);
        const unsigned gen = old / nloc;
        if (old + 1u == (gen + 1u) * nloc) {
            __builtin_amdgcn_fence(__ATOMIC_RELEASE, "agent");
            asm volatile("s_waitcnt vmcnt(0)" ::: "memory");
            const unsigned og = xb_add(&bar[XB_TOP], 1u);
            const unsigned tg = og / nx;
            if (og + 1u == (tg + 1u) * nx) xb_add(&bar[XB_TOPGEN], 1u);
            else XB_SPIN(xb_ld(&bar[XB_TOPGEN]) == tg, bar);
            __builtin_amdgcn_fence(__ATOMIC_ACQUIRE, "agent");
            xb_add(&bar[XB_XGEN(b.x)], 1u);
            asm volatile("s_waitcnt vmcnt(0)" ::: "memory");
        } else {
            XB_SPIN(xb_ld(&bar[XB_XGEN(b.x)]) == gen, bar);
            __builtin_amdgcn_fence(__ATOMIC_ACQUIRE, "agent");
            asm volatile("s_waitcnt vmcnt(0)" ::: "memory");
        }
    }
    __syncthreads();
}

constexpr int NWAVES = 8;
constexpr int D = 1024, FF = 2816, MP = 16384, MS = 512, M = MP + MS;
constexpr int PSH = 1792, PTOT = 3328, OFF_V = 1024, OFF_WD = 1536, OFF_CB = 1792, OFF_CC = 2304, OFF_CH = 2816;
constexpr int NH = 8, DR = 512;
constexpr int NGU = 2 * FF;
constexpr int NLORA = 1536, KLORA = 256;
constexpr float ALPHA = 1.189207115002721f;
constexpr float LN_EPS = 1e-5f, GN_EPS = 64e-5f;
constexpr size_t O_Y = 0, O_WKVP = (size_t)M * D, O_SHP = O_WKVP + 8 * 8 * 4096, O_CVP = O_SHP + 8 * PSH, O_WKVS = O_CVP + 8 * 2 * 512,
                 O_SHS = O_WKVS + (size_t)128 * 8 * 4096, O_CVS = O_SHS + 128 * PSH, O_END = O_CVS + 128 * 2 * 512;
constexpr size_t MiB = 1u << 20;
constexpr size_t WS_CTL = 0, CTL_ZERO_BYTES = 64 * 1024;
constexpr size_t WS_WGU1 = 1 * MiB, WS_WD1 = 12 * MiB, WS_WGU2 = 18 * MiB, WS_WD2 = 29 * MiB, WS_WIN = 35 * MiB, WS_WOUT = 42 * MiB, WS_WL = 44 * MiB;
constexpr size_t WS_XB = 45 * MiB;
constexpr size_t WS_BONUS = 78 * MiB;
constexpr size_t WS_H = 79 * MiB;
constexpr size_t WS_PROJ = 79 * MiB;
constexpr size_t WS_AP = 187 * MiB;
constexpr size_t WS_MIX = 196 * MiB;
constexpr size_t WS_END = 230 * MiB;
constexpr int CW_BAR = 1024;
static_assert((CW_BAR + XCD_BAR_WORDS) * 4 <= (int)CTL_ZERO_BYTES, "ctl");
constexpr int RING_BYTES = 131072, MISC_OFF = 143360, LDS_BYTES = 147456;

__device__ __forceinline__ float bf2f(unsigned short b) { return __builtin_bit_cast(float, (unsigned)b << 16); }
__device__ __forceinline__ float bflo(unsigned w) { return __builtin_bit_cast(float, w << 16); }
__device__ __forceinline__ float bfhi(unsigned w) { return __builtin_bit_cast(float, w & 0xffff0000u); }
__device__ __forceinline__ unsigned pkbf(float lo, float hi) { return pg8::cvt_pk_bf16(lo, hi); }
__device__ __forceinline__ float wave_sum(float v) {
#pragma unroll
    for (int o = 1; o < 64; o <<= 1) v += __shfl_xor(v, o);
    return v;
}
__device__ __forceinline__ float sigmoidf_(float x) { return 1.0f / (1.0f + __expf(-x)); }

struct Args { const float* in[31]; float* out; unsigned char* ws; };
enum { I_XP = 0, I_XS, I_SWKV, I_SSH, I_SCV, I_LN1G, I_LN1B, I_F1G, I_F1U, I_F1D, I_WIN, I_MU, I_W0, I_WLU, I_A0, I_ALU, I_GLU, I_KK, I_KA, I_RK, I_LNXG, I_LNXB, I_CW, I_WOUT,
       I_LN2G, I_LN2B, I_F2G, I_F2U, I_F2D, I_LN3G, I_LN3B };

namespace pg8 {
struct EpiSwiGLU {
    static constexpr bool PERM = true, AFTER_DRAIN = false;
    bf16_t* O; int ldc;
    __device__ __forceinline__ void operator()(const f32x4 (&acc)[2][2][4][2], const Unit& u, int wr, int wc, int fr, int fq) const {
        const int row0 = u.pm * BM + wr * 64 + fr, col0 = u.pn * 128 + wc * 32 + 8 * fq;
#pragma unroll
        for (int ai = 0; ai < 2; ++ai)
#pragma unroll
            for (int m = 0; m < 4; ++m) { bf16_t* rowp = O + (size_t)(row0 + ai * HALF + m * 16) * ldc + col0; float hv[8];
#pragma unroll
                for (int n = 0; n < 2; ++n)
#pragma unroll
                    for (int e = 0; e < 4; ++e) { const float g = acc[ai][0][m][n][e], up = acc[ai][1][m][n][e]; hv[n * 4 + e] = g * __builtin_amdgcn_rcpf(1.0f + __expf(-g)) * up; }
                u32x4 w; w.x = cvt_pk_bf16(hv[0], hv[1]); w.y = cvt_pk_bf16(hv[2], hv[3]); w.z = cvt_pk_bf16(hv[4], hv[5]); w.w = cvt_pk_bf16(hv[6], hv[7]);
                *(u32x4*)rowp = w; }
    }
};
template <bool RES_BF16> struct EpiRes {
    static constexpr bool PERM = false, AFTER_DRAIN = false;
    const void* r0; const void* r1; int split_pm; float* out; int ldc; float alpha, beta;
    __device__ __forceinline__ void operator()(const f32x4 (&acc)[2][2][4][2], const Unit& u, int wr, int wc, int fr, int fq) const {
        const int col0 = u.pn * BM + wc * 32 + 4 * fq;
        const char* rb = (const char*)(u.pm < split_pm ? r0 : r1); const int rrow0 = (u.pm < split_pm ? u.pm : u.pm - split_pm) * BM;
#pragma unroll
        for (int ai = 0; ai < 2; ++ai)
#pragma unroll
            for (int m = 0; m < 4; ++m) { const int rl = ai * HALF + wr * 64 + m * 16 + fr; const size_t off = (size_t)(u.pm * BM + rl) * ldc + col0; const size_t roff = (size_t)(rrow0 + rl) * ldc + col0;
#pragma unroll
                for (int bj = 0; bj < 2; ++bj)
#pragma unroll
                    for (int n = 0; n < 2; ++n) { f32x4 rv;
                        if (RES_BF16) { typedef unsigned u32x2v __attribute__((ext_vector_type(2))); const u32x2v w = *(const u32x2v*)(rb + (roff + bj * HALF + n * 16) * 2);
                            rv = (f32x4){__builtin_bit_cast(float, w.x << 16), __builtin_bit_cast(float, w.x & 0xffff0000u), __builtin_bit_cast(float, w.y << 16), __builtin_bit_cast(float, w.y & 0xffff0000u)}; }
                        else rv = *(const f32x4*)(rb + (roff + bj * HALF + n * 16) * 4);
                        *(f32x4*)(out + off + bj * HALF + n * 16) = rv * alpha + acc[ai][bj][m][n] * beta; } }
    }
};
}

struct Frame {
    LAS unsigned char* lds; int tid, lane, wave, gw, NGW, G;
};

__device__ __forceinline__ void p0_transpose_item(const float* W, int N, bf16* WT, int ldt, int coff, int drow0, LAS float* scr, int k0, int n0, int lane) {
#pragma unroll 8
    for (int i = 0; i < 32; ++i) { const int kk = 2 * i + (lane >> 5); scr[kk * 33 + (lane & 31)] = W[(size_t)(k0 + kk) * N + n0 + (lane & 31)]; }
    LDS_WAIT(); asm volatile("" ::: "memory");
    const int c = lane & 7;
#pragma unroll
    for (int j = 0; j < 4; ++j) { const int n = (lane >> 3) + 8 * j; const LAS float* s = scr + (8 * c) * 33 + n;
        v4u o; o.x = pkbf(s[0 * 33], s[1 * 33]); o.y = pkbf(s[2 * 33], s[3 * 33]); o.z = pkbf(s[4 * 33], s[5 * 33]); o.w = pkbf(s[6 * 33], s[7 * 33]);
        *(GAS v4u*)(WT + (size_t)(drow0 + n) * ldt + coff + k0 + 8 * c) = o; }
    LDS_WAIT(); asm volatile("" ::: "memory");
}

__device__ __forceinline__ void phase_prologue(const Args& A, Frame& F) {
    unsigned char* ws = A.ws;
    LAS float* scr = (LAS float*)(F.lds + F.wave * 16384);
    constexpr int I_GU = 16 * 88, I_DN = 44 * 32, I_IN = 16 * 104, I_OUT = 16 * 32, I_L64 = 16, I_L128 = 32;
    constexpr int NITEMS = 6 * I_GU + I_IN + I_OUT + 2 * I_L64 + I_L128;
    static_assert(I_GU == I_DN, "");
    for (int it = F.gw; it < NITEMS; it += F.NGW) {
        int r = it;
        if (r < 6 * I_GU) { const int mtx = r / I_GU; r -= mtx * I_GU; const int f2 = mtx >= 3, kind = mtx % 3;
            if (kind < 2) { const int nblk = FF / 32, kb = r / nblk, nb = r % nblk, n0 = nb * 32; const int drow = (n0 >> 7) * 256 + (n0 & 127) + kind * 128;
                p0_transpose_item(A.in[(f2 ? I_F2G : I_F1G) + kind], FF, (bf16*)(ws + (f2 ? WS_WGU2 : WS_WGU1)), D, 0, drow, scr, kb * 64, n0, F.lane); }
            else { const int nblk = D / 32, kb = r / nblk, nb = r % nblk;
                p0_transpose_item(A.in[f2 ? I_F2D : I_F1D], D, (bf16*)(ws + (f2 ? WS_WD2 : WS_WD1)), FF, 0, nb * 32, scr, kb * 64, nb * 32, F.lane); }
            continue; }
        r -= 6 * I_GU;
        if (r < I_IN) { const int nblk = PTOT / 32, kb = r / nblk, nb = r % nblk; p0_transpose_item(A.in[I_WIN], PTOT, (bf16*)(ws + WS_WIN), D, 0, nb * 32, scr, kb * 64, nb * 32, F.lane); continue; }
        r -= I_IN;
        if (r < I_OUT) { const int nblk = D / 32, kb = r / nblk, nb = r % nblk; p0_transpose_item(A.in[I_WOUT], D, (bf16*)(ws + WS_WOUT), D, 0, nb * 32, scr, kb * 64, nb * 32, F.lane); continue; }
        r -= I_OUT;
        if (r < I_L64) { p0_transpose_item(A.in[I_WLU], 512, (bf16*)(ws + WS_WL), KLORA, 0, r * 32, scr, 0, r * 32, F.lane); continue; }
        r -= I_L64;
        if (r < I_L64) { p0_transpose_item(A.in[I_ALU], 512, (bf16*)(ws + WS_WL), KLORA, 64, 512 + r * 32, scr, 0, r * 32, F.lane); continue; }
        r -= I_L64;
        { const int kb = r / 16, nb = r % 16; p0_transpose_item(A.in[I_GLU], 512, (bf16*)(ws + WS_WL), KLORA, 128, 1024 + nb * 32, scr, kb * 64, nb * 32, F.lane); }
    }
    { const int gt = F.gw * 64 + F.lane, NT = F.NGW * 64;
      for (int ch = gt; ch < NLORA * KLORA / 8; ch += NT) { const int row = ch >> 5, col = (ch & 31) * 8; const int ty = row >> 9;
          const bool nz = ty == 0 ? (col < 64) : (ty == 1 ? (col >= 64 && col < 128) : (col >= 128));
          if (!nz) *(GAS v4u*)((bf16*)(ws + WS_WL) + (size_t)row * KLORA + col) = (v4u){0u, 0u, 0u, 0u}; } }
    for (int m = F.gw; m < M; m += F.NGW) {
        const float* xrow = m < MP ? A.in[I_XP] + (size_t)m * D : A.in[I_XS] + (size_t)(m - MP) * D;
        const GAS f32x4* xr = (const GAS f32x4*)xrow + F.lane; GAS unsigned long long* o8 = (GAS unsigned long long*)((bf16*)(ws + WS_XB) + (size_t)m * D) + F.lane;
#pragma unroll
        for (int j = 0; j < 4; ++j) { const f32x4 v = xr[64 * j]; o8[64 * j] = (unsigned long long)pkbf(v.x, v.y) | ((unsigned long long)pkbf(v.z, v.w) << 32); }
    }
}

template <bool FINAL> __device__ __forceinline__ void phase_ln(Frame& F, float* z, bf16* xb, const float* g, const float* b) {
    f32x4 gv[4], bv[4];
#pragma unroll
    for (int j = 0; j < 4; ++j) { gv[j] = ((const GAS f32x4*)g)[F.lane + 64 * j]; bv[j] = ((const GAS f32x4*)b)[F.lane + 64 * j]; }
    for (int m = F.gw; m < M; m += F.NGW) {
        GAS f32x4* xr = (GAS f32x4*)(z + (size_t)m * D) + F.lane;
        f32x4 v[4]; float s = 0.f;
#pragma unroll
        for (int j = 0; j < 4; ++j) { v[j] = xr[64 * j]; s += (v[j].x + v[j].y) + (v[j].z + v[j].w); }
        const float mean = wave_sum(s) * (1.f / D); float s2 = 0.f;
#pragma unroll
        for (int j = 0; j < 4; ++j) { v[j] = v[j] - mean; s2 += (v[j].x * v[j].x + v[j].y * v[j].y) + (v[j].z * v[j].z + v[j].w * v[j].w); }
        const float rstd = 1.f / sqrtf(wave_sum(s2) * (1.f / D) + LN_EPS);
        if (FINAL) {
#pragma unroll
            for (int j = 0; j < 4; ++j) xr[64 * j] = v[j] * rstd * gv[j] + bv[j];
        } else {
            GAS unsigned long long* o8 = (GAS unsigned long long*)(xb + (size_t)m * D) + F.lane;
#pragma unroll
            for (int j = 0; j < 4; ++j) { const f32x4 o = v[j] * rstd * gv[j] + bv[j]; o8[64 * j] = (unsigned long long)pkbf(o.x, o.y) | ((unsigned long long)pkbf(o.z, o.w) << 32); }
        }
    }
}

struct Tok { int s, t, T; bool prompt; };
__device__ __forceinline__ Tok tok_of(int n) { Tok k; k.prompt = n < MP; if (k.prompt) { k.s = n >> 11; k.t = n & 2047; k.T = 2048; } else { const int r = n - MP; k.s = r >> 2; k.t = r & 3; k.T = 4; } return k; }

__device__ __forceinline__ void phase_prep(const Args& A, Frame& F) {
    unsigned char* ws = A.ws; const bf16* proj = (const bf16*)(ws + WS_PROJ); bf16* ap = (bf16*)(ws + WS_AP); bf16* mix = (bf16*)(ws + WS_MIX);
    const int lane = F.lane;
    const f32x4 mu4 = *(const GAS f32x4*)(A.in[I_MU] + OFF_WD + 4 * lane);
    float cw[3][8];
#pragma unroll
    for (int i = 0; i < 3; ++i)
#pragma unroll
        for (int e = 0; e < 8; ++e) cw[i][e] = A.in[I_CW][i * 512 + 8 * lane + e];
    typedef unsigned u32x2v __attribute__((ext_vector_type(2)));
    for (int n = F.gw; n < M; n += F.NGW) {
        const Tok k = tok_of(n); const bf16* pr = proj + (size_t)n * PTOT;
        { const u32x2v c = *(const GAS u32x2v*)(pr + OFF_WD + 4 * lane); f32x4 cur = (f32x4){bflo(c.x), bfhi(c.x), bflo(c.y), bfhi(c.y)}, prev;
          if (k.t > 0) { const u32x2v p = *(const GAS u32x2v*)(pr - PTOT + OFF_WD + 4 * lane); prev = (f32x4){bflo(p.x), bfhi(p.x), bflo(p.y), bfhi(p.y)}; }
          else if (!k.prompt) prev = *(const GAS f32x4*)(A.in[I_SSH] + (size_t)k.s * PSH + OFF_WD + 4 * lane);
          else prev = (f32x4){0.f, 0.f, 0.f, 0.f};
          f32x4 m = cur + mu4 * (prev - cur);
          if (lane < 16) { m.x = tanhf(m.x); m.y = tanhf(m.y); m.z = tanhf(m.z); m.w = tanhf(m.w); }
          else if (lane >= 32) { m.x = sigmoidf_(m.x); m.y = sigmoidf_(m.y); m.z = sigmoidf_(m.z); m.w = sigmoidf_(m.w); }
          u32x2v o; o.x = pkbf(m.x, m.y); o.y = pkbf(m.z, m.w); *(GAS u32x2v*)(ap + (size_t)n * KLORA + 4 * lane) = o; }
        { const v4u cbw = *(const GAS v4u*)(pr + OFF_CB + 8 * lane), ccw = *(const GAS v4u*)(pr + OFF_CC + 8 * lane), chw = *(const GAS v4u*)(pr + OFF_CH + 8 * lane);
          float u2[8], u1[8], u0[8], cb[8];
#pragma unroll
          for (int e = 0; e < 4; ++e) { u2[2 * e] = bflo(ccw[e]) * bflo(chw[e]); u2[2 * e + 1] = bfhi(ccw[e]) * bfhi(chw[e]); cb[2 * e] = bflo(cbw[e]); cb[2 * e + 1] = bfhi(cbw[e]); }
          const float* sc = A.in[I_SCV] + (size_t)k.s * 1024 + 8 * lane;
          if (k.t >= 1) { const v4u a = *(const GAS v4u*)(pr - PTOT + OFF_CC + 8 * lane), b = *(const GAS v4u*)(pr - PTOT + OFF_CH + 8 * lane);
#pragma unroll
              for (int e = 0; e < 4; ++e) { u1[2 * e] = bflo(a[e]) * bflo(b[e]); u1[2 * e + 1] = bfhi(a[e]) * bfhi(b[e]); } }
          else {
#pragma unroll
              for (int e = 0; e < 8; ++e) u1[e] = k.prompt ? 0.f : sc[512 + e]; }
          if (k.t >= 2) { const v4u a = *(const GAS v4u*)(pr - 2 * PTOT + OFF_CC + 8 * lane), b = *(const GAS v4u*)(pr - 2 * PTOT + OFF_CH + 8 * lane);
#pragma unroll
              for (int e = 0; e < 4; ++e) { u0[2 * e] = bflo(a[e]) * bflo(b[e]); u0[2 * e + 1] = bfhi(a[e]) * bfhi(b[e]); } }
          else {
#pragma unroll
              for (int e = 0; e < 8; ++e) u0[e] = k.prompt ? 0.f : sc[k.t * 512 + e]; }
          float y[8];
#pragma unroll
          for (int e = 0; e < 8; ++e) y[e] = cb[e] * (cw[0][e] * u0[e] + cw[1][e] * u1[e] + cw[2][e] * u2[e]);
          v4u o; o.x = pkbf(y[0], y[1]); o.y = pkbf(y[2], y[3]); o.z = pkbf(y[4], y[5]); o.w = pkbf(y[6], y[7]);
          *(GAS v4u*)(mix + (size_t)n * D + 512 + 8 * lane) = o;
          if (k.t >= k.T - 2) { float* co = A.out + (k.prompt ? O_CVP : O_CVS) + ((size_t)k.s * 2 + (k.t - (k.T - 2))) * 512 + 8 * lane;
              *(GAS f32x4*)co = (f32x4){u2[0], u2[1], u2[2], u2[3]}; *(GAS f32x4*)(co + 4) = (f32x4){u2[4], u2[5], u2[6], u2[7]}; } }
        if (k.t == k.T - 1) { float* so = A.out + (k.prompt ? O_SHP : O_SHS) + (size_t)k.s * PSH;
#pragma unroll
            for (int i = 0; i < 7; ++i) { const u32x2v c = *(const GAS u32x2v*)(pr + 256 * i + 4 * lane); *(GAS f32x4*)(so + 256 * i + 4 * lane) = (f32x4){bflo(c.x), bfhi(c.x), bflo(c.y), bfhi(c.y)}; } }
    }
}

constexpr int TC = 32, RB_TOK = 320, RB_VT = TC * RB_TOK, VT_LD = 36, RB_FLOATS = RB_VT + 64 * VT_LD;
constexpr int REC_OBUF_OFF = 2 * RB_FLOATS * 4;
static_assert(REC_OBUF_OFF + 4 * TC * 64 * 4 <= MISC_OFF - 320, "recurrence LDS");
__device__ __forceinline__ float row16_allsum(float x) {
    x += __builtin_bit_cast(float, __builtin_amdgcn_update_dpp(0, __builtin_bit_cast(int, x), 0x128, 0xf, 0xf, false));
    x += __builtin_bit_cast(float, __builtin_amdgcn_update_dpp(0, __builtin_bit_cast(int, x), 0x124, 0xf, 0xf, false));
    x += __builtin_bit_cast(float, __builtin_amdgcn_update_dpp(0, __builtin_bit_cast(int, x), 0x122, 0xf, 0xf, false));
    x += __builtin_bit_cast(float, __builtin_amdgcn_update_dpp(0, __builtin_bit_cast(int, x), 0x121, 0xf, 0xf, false));
    return x;
}
struct RecItem { int n0, ntok, s, h, q; bool prompt; };
__device__ __forceinline__ RecItem rec_item(int b, int i) {
    RecItem it;
    if (i < 64) { it.prompt = true; it.s = b >> 5; it.h = (b >> 2) & 7; it.q = b & 3; it.n0 = it.s * 2048 + TC * i; it.ntok = TC; }
    else { const int su = b * 4 + (i - 64); it.prompt = false; it.s = su >> 3; it.h = su & 7; it.q = 0; it.n0 = MP + it.s * 4; it.ntok = 4; }
    return it;
}
struct RecPar { float mur, muk, muv, kkp, kap, rkp, w0p, a0p; };
struct RecRaw { unsigned short rr[9], kr[9], vr[9], ar[8], wr[8]; float fp[3]; RecPar P; };
__device__ __forceinline__ void rec_emit(const RecPar& P, float r, float k, float v, float araw, float wraw, LAS float* buf, int tt, int lane, float* bonus_out) {
    const float a = sigmoidf_(P.a0p + araw), w = __expf(-0.6065306597126334f * sigmoidf_(P.w0p + wraw));
    const float kkr = k * P.kkp; const float ss2 = wave_sum(kkr * kkr); const float kk = kkr / fmaxf(sqrtf(ss2), 1e-12f);
    const float k2 = k * (1.0f + (a - 1.0f) * P.kap), nb = -kk * a;
    const float bon = wave_sum(r * k2 * P.rkp);
    if (bonus_out && lane == 0) *bonus_out = bon;
    LAS float* bt = buf + tt * RB_TOK;
    bt[lane] = r; bt[64 + lane] = w; bt[128 + lane] = k2; bt[192 + lane] = kk; bt[256 + lane] = nb; buf[RB_VT + lane * VT_LD + tt] = v;
}
__device__ __forceinline__ void rec_load_raw(const Args& A, const RecItem& it, int pw, int lane, RecRaw& R) {
    const bf16* proj = (const bf16*)(A.ws + WS_PROJ); const bf16* lora = (const bf16*)A.out;
    const int c = it.h * 64 + lane;
    R.P.mur = A.in[I_MU][c]; R.P.muk = A.in[I_MU][512 + c]; R.P.muv = A.in[I_MU][1024 + c]; R.P.kkp = A.in[I_KK][c]; R.P.kap = A.in[I_KA][c]; R.P.rkp = A.in[I_RK][c]; R.P.w0p = A.in[I_W0][c]; R.P.a0p = A.in[I_A0][c];
    if (it.prompt) {
        const int n1 = it.n0 + pw * 8; const bool has_prev = (n1 & 2047) != 0;
        const bf16* pr = proj + (size_t)n1 * PTOT + c; const bf16* lr = lora + (size_t)n1 * NLORA + c;
        R.rr[0] = 0; R.kr[0] = 0; R.vr[0] = 0;
        if (has_prev) { R.rr[0] = pr[-PTOT]; R.kr[0] = pr[512 - PTOT]; R.vr[0] = pr[1024 - PTOT]; }
#pragma unroll
        for (int i = 0; i < 8; ++i) { R.rr[i + 1] = pr[(size_t)i * PTOT]; R.kr[i + 1] = pr[(size_t)i * PTOT + 512]; R.vr[i + 1] = pr[(size_t)i * PTOT + 1024]; R.wr[i] = lr[(size_t)i * NLORA]; R.ar[i] = lr[(size_t)i * NLORA + 512]; }
    } else {
        const int tt = pw, n = it.n0 + tt; const bf16* pr = proj + (size_t)n * PTOT + c;
        R.rr[1] = pr[0]; R.kr[1] = pr[512]; R.vr[1] = pr[1024]; R.ar[0] = lora[(size_t)n * NLORA + 512 + c]; R.wr[0] = lora[(size_t)n * NLORA + c];
        if (tt > 0) { R.fp[0] = bf2f(pr[-PTOT]); R.fp[1] = bf2f(pr[512 - PTOT]); R.fp[2] = bf2f(pr[1024 - PTOT]); }
        else { const float* ss = A.in[I_SSH] + (size_t)it.s * PSH + c; R.fp[0] = ss[0]; R.fp[1] = ss[512]; R.fp[2] = ss[1024]; }
    }
}
__device__ __forceinline__ void rec_compute(const Args& A, const RecItem& it, bool has_nx, const RecItem& nx, int pw, int lane, RecRaw& R, LAS float* buf) {
    float* bonus = (float*)(A.ws + WS_BONUS); const RecPar P = R.P;
    if (it.prompt) {
        const int n1 = it.n0 + pw * 8; const bool inter = has_nx && nx.prompt;
        const int m1 = nx.n0 + pw * 8; const bool nx_prev = (m1 & 2047) != 0;
        const bf16* pr = (const bf16*)(A.ws + WS_PROJ) + (size_t)m1 * PTOT + it.h * 64 + lane; const bf16* lr = (const bf16*)A.out + (size_t)m1 * NLORA + it.h * 64 + lane;
        LAS float* b0 = buf + (pw * 8) * RB_TOK;
        float vr_[8], vw_[8], vk2[8], vkkr[8], va[8], vv[8];
#pragma unroll
        for (int i = 0; i < 8; ++i) {
            const float rc = bf2f(R.rr[i + 1]), kc = bf2f(R.kr[i + 1]), vc = bf2f(R.vr[i + 1]), rp = bf2f(R.rr[i]), kp = bf2f(R.kr[i]), vp = bf2f(R.vr[i]);
            const float ai = bf2f(R.ar[i]), wi = bf2f(R.wr[i]);
            if (inter) {
                if (i > 0 || nx_prev) { R.rr[i] = pr[(ptrdiff_t)(i - 1) * PTOT]; R.kr[i] = pr[(ptrdiff_t)(i - 1) * PTOT + 512]; R.vr[i] = pr[(ptrdiff_t)(i - 1) * PTOT + 1024]; } else { R.rr[0] = 0; R.kr[0] = 0; R.vr[0] = 0; }
                R.wr[i] = lr[(size_t)i * NLORA]; R.ar[i] = lr[(size_t)i * NLORA + 512];
                if (i == 7) { R.rr[8] = pr[(size_t)7 * PTOT]; R.kr[8] = pr[(size_t)7 * PTOT + 512]; R.vr[8] = pr[(size_t)7 * PTOT + 1024]; } }
            const float r = rc + P.mur * (rp - rc), k = kc + P.muk * (kp - kc); vv[i] = vc + P.muv * (vp - vc);
            const float a = sigmoidf_(P.a0p + ai); vw_[i] = __expf(-0.6065306597126334f * sigmoidf_(P.w0p + wi));
            const float kkr = k * P.kkp, k2 = k * (1.0f + (a - 1.0f) * P.kap);
            vr_[i] = r; vk2[i] = k2; vkkr[i] = kkr; va[i] = a;
            b0[i * RB_TOK + lane] = kkr * kkr; b0[i * RB_TOK + 64 + lane] = r * k2 * P.rkp;
        }
        { const int sidx = lane >> 2, tok = sidx & 7, which = sidx >> 3, part = lane & 3;
          const LAS f32x4* p = (const LAS f32x4*)(b0 + tok * RB_TOK + which * 64 + part * 16);
          const f32x4 s4 = (p[0] + p[1]) + (p[2] + p[3]); float s = (s4.x + s4.y) + (s4.z + s4.w);
          s += __builtin_bit_cast(float, __builtin_amdgcn_update_dpp(0, __builtin_bit_cast(int, s), 0xB1, 0xf, 0xf, false));
          s += __builtin_bit_cast(float, __builtin_amdgcn_update_dpp(0, __builtin_bit_cast(int, s), 0x4E, 0xf, 0xf, false));
          const float rn = 1.0f / fmaxf(sqrtf(s), 1e-12f);
          if (part == 0) { if (which == 0) b0[128 + tok] = rn; else if (it.q == 0) bonus[(size_t)(n1 + tok) * 8 + it.h] = s; } }
        const f32x4 rn0 = *(const LAS f32x4*)(b0 + 128), rn1 = *(const LAS f32x4*)(b0 + 132);
#pragma unroll
        for (int i = 0; i < 8; ++i) { const float rn = i < 4 ? rn0[i & 3] : rn1[i & 3]; const float kk = vkkr[i] * rn; LAS float* bt = b0 + i * RB_TOK;
            bt[lane] = vr_[i]; bt[64 + lane] = vw_[i]; bt[128 + lane] = vk2[i]; bt[192 + lane] = kk; bt[256 + lane] = -kk * va[i]; buf[RB_VT + lane * VT_LD + pw * 8 + i] = vv[i]; }
        if (has_nx && !inter) rec_load_raw(A, nx, pw, lane, R);
    } else {
        const int tt = pw, n = it.n0 + tt; const float rc = bf2f(R.rr[1]), kc = bf2f(R.kr[1]), vc = bf2f(R.vr[1]);
        const float f0 = R.fp[0], f1 = R.fp[1], f2 = R.fp[2], ai = bf2f(R.ar[0]), wi = bf2f(R.wr[0]);
        if (has_nx) rec_load_raw(A, nx, pw, lane, R);
        rec_emit(P, rc + P.mur * (f0 - rc), kc + P.muk * (f1 - kc), vc + P.muv * (f2 - vc), ai, wi, buf, tt, lane, bonus + (size_t)n * 8 + it.h);
    }
}
typedef float f32x2 __attribute__((ext_vector_type(2)));
struct RV { f32x4 kk, w, nb, k, r; };
__device__ __forceinline__ void rec_load(RV& X, const LAS float* bt, int l) {
    X.kk = *(const LAS f32x4*)(bt + 192 + 4 * l); X.w = *(const LAS f32x4*)(bt + 64 + 4 * l); X.nb = *(const LAS f32x4*)(bt + 256 + 4 * l);
    X.k = *(const LAS f32x4*)(bt + 128 + 4 * l); X.r = *(const LAS f32x4*)(bt + 4 * l);
}
__device__ __forceinline__ float rec_comp(f32x4& S, const RV& X, float vi) {
    f32x2 p = S.xy * X.kk.xy; p = S.zw * X.kk.zw + p; float d_ = row16_allsum(p.x + p.y);
    const f32x4 T_ = S * X.w + X.k * vi; S = T_ + X.nb * d_;
    f32x2 q = S.xy * X.r.xy; q = S.zw * X.r.zw + q; return q.x + q.y;
}
__device__ __forceinline__ void phase_recurrence(const Args& A, Frame& F) {
    LAS float* bufs = (LAS float*)F.lds;
    LAS float* obuf = (LAS float*)(F.lds + REC_OBUF_OFF) + (F.wave & 3) * (TC * 64);
    bf16* mix = (bf16*)(A.ws + WS_MIX);
    const int b = blockIdx.x, lane = F.lane, w = F.wave, l = lane & 15, rg = lane >> 4;
    constexpr int NIT = 68;
    f32x4 S = (f32x4){0.f, 0.f, 0.f, 0.f};
    RecRaw R;
    if (w >= 4) { rec_load_raw(A, rec_item(b, 0), w - 4, lane, R); rec_compute(A, rec_item(b, 0), true, rec_item(b, 1), w - 4, lane, R, bufs); }
    __syncthreads();
    for (int i = 0; i < NIT; ++i) {
        if (w >= 4) {
            if (i + 1 < NIT) rec_compute(A, rec_item(b, i + 1), i + 2 < NIT, rec_item(b, i + 2 < NIT ? i + 2 : i + 1), w - 4, lane, R, bufs + ((i + 1) & 1) * RB_FLOATS);
        } else {
            __builtin_amdgcn_s_setprio(2);
            const RecItem it = rec_item(b, i); const LAS float* buf = bufs + (i & 1) * RB_FLOATS;
            if (it.prompt) {
                const int irow = it.q * 16 + w * 4 + rg; const LAS float* vrow = buf + RB_VT + irow * VT_LD; float opv[TC];
f32x4 v4[TC / 4];
#pragma unroll
                for (int t4 = 0; t4 < TC / 4; ++t4) v4[t4] = *(const LAS f32x4*)(vrow + 4 * t4);
                RV X[2]; rec_load(X[0], buf, l);
#pragma unroll
                for (int t = 0; t < TC; ++t) {
                    if (t + 1 < TC) rec_load(X[(t + 1) & 1], buf + (t + 1) * RB_TOK, l);
                    __builtin_amdgcn_sched_barrier(0);
                    opv[t] = rec_comp(S, X[t & 1], v4[t >> 2][t & 3]);
                    __builtin_amdgcn_sched_barrier(0);
                }
#pragma unroll
                for (int t = 0; t < TC; ++t) obuf[t * 64 + lane] = opv[t];
                { const int t = lane >> 1, pr2 = lane & 1; const LAS f32x4* p0 = (const LAS f32x4*)(obuf + t * 64 + pr2 * 32);
                  const f32x4 a0 = p0[0], a1 = p0[1], a2 = p0[2], a3 = p0[3], b0 = p0[4], b1 = p0[5], b2 = p0[6], b3 = p0[7];
                  const f32x4 sa = (a0 + a1) + (a2 + a3), sb = (b0 + b1) + (b2 + b3);
                  const float o0 = (sa.x + sa.y) + (sa.z + sa.w), o1 = (sb.x + sb.y) + (sb.z + sb.w);
                  *(GAS unsigned*)(mix + (size_t)(it.n0 + t) * D + it.h * 64 + it.q * 16 + w * 4 + 2 * pr2) = pkbf(o0, o1); }
                if (i == 63) *(GAS f32x4*)(A.out + O_WKVP + ((size_t)(it.s * 8 + it.h) * 64 + irow) * 64 + 4 * l) = S;
            } else {
                f32x4 Sq[4]; float ops[16];
#pragma unroll
                for (int qq = 0; qq < 4; ++qq) Sq[qq] = *(const GAS f32x4*)(A.in[I_SWKV] + ((size_t)(it.s * 8 + it.h) * 64 + qq * 16 + w * 4 + rg) * 64 + 4 * l);
#pragma unroll
                for (int qq = 0; qq < 4; ++qq) { const int irow = qq * 16 + w * 4 + rg; const f32x4 v4 = *(const LAS f32x4*)(buf + RB_VT + irow * VT_LD);
#pragma unroll
                    for (int t = 0; t < 4; ++t) { RV X; rec_load(X, buf + t * RB_TOK, l); ops[t * 4 + qq] = rec_comp(Sq[qq], X, v4[t]); }
                    *(GAS f32x4*)(A.out + O_WKVS + ((size_t)(it.s * 8 + it.h) * 64 + irow) * 64 + 4 * l) = Sq[qq]; }
#pragma unroll
                for (int x = 0; x < 16; ++x) obuf[x * 64 + lane] = ops[x];
                { const int t = lane >> 4, qq = (lane >> 2) & 3, rr = lane & 3; const LAS f32x4* p0 = (const LAS f32x4*)(obuf + (t * 4 + qq) * 64 + rr * 16);
                  const f32x4 sa = (p0[0] + p0[1]) + (p0[2] + p0[3]); const float o = (sa.x + sa.y) + (sa.z + sa.w);
                  mix[(size_t)(it.n0 + t) * D + it.h * 64 + qq * 16 + w * 4 + rr] = (bf16)(pkbf(o, 0.f) & 0xffffu); }
            }
            __builtin_amdgcn_s_setprio(0);
        }
        __syncthreads();
    }
}

__device__ __forceinline__ void phase_post(const Args& A, Frame& F) {
    unsigned char* ws = A.ws; const bf16* proj = (const bf16*)(ws + WS_PROJ); bf16* mix = (bf16*)(ws + WS_MIX);
    const bf16* recg = (const bf16*)A.out + 1024;   const float* bonus = (const float*)(ws + WS_BONUS);
    const int lane = F.lane, c0 = 8 * lane, h = lane >> 3;
    float muv[8], lg[8], lb[8];
#pragma unroll
    for (int e = 0; e < 8; ++e) { muv[e] = A.in[I_MU][OFF_V + c0 + e]; lg[e] = A.in[I_LNXG][c0 + e]; lb[e] = A.in[I_LNXB][c0 + e]; }
    for (int n = F.gw; n < M; n += F.NGW) {
        const Tok k = tok_of(n);
        const v4u ow = *(const GAS v4u*)(mix + (size_t)n * D + c0), gw4 = *(const GAS v4u*)(recg + (size_t)n * NLORA + c0), vcw = *(const GAS v4u*)(proj + (size_t)n * PTOT + OFF_V + c0);
        float o[8], g[8], v[8], vp[8];
#pragma unroll
        for (int e = 0; e < 4; ++e) { o[2 * e] = bflo(ow[e]); o[2 * e + 1] = bfhi(ow[e]); g[2 * e] = bflo(gw4[e]); g[2 * e + 1] = bfhi(gw4[e]); v[2 * e] = bflo(vcw[e]); v[2 * e + 1] = bfhi(vcw[e]); }
        if (k.t > 0) { const v4u pw4 = *(const GAS v4u*)(proj + (size_t)(n - 1) * PTOT + OFF_V + c0);
#pragma unroll
            for (int e = 0; e < 4; ++e) { vp[2 * e] = bflo(pw4[e]); vp[2 * e + 1] = bfhi(pw4[e]); } }
        else {
#pragma unroll
            for (int e = 0; e < 8; ++e) vp[e] = k.prompt ? 0.f : A.in[I_SSH][(size_t)k.s * PSH + OFF_V + c0 + e]; }
        float s = 0.f;
#pragma unroll
        for (int e = 0; e < 8; ++e) s += o[e];
        s += __shfl_xor(s, 1); s += __shfl_xor(s, 2); s += __shfl_xor(s, 4);
        const float mean = s * (1.f / 64.f); float q = 0.f;
#pragma unroll
        for (int e = 0; e < 8; ++e) { o[e] -= mean; q += o[e] * o[e]; }
        q += __shfl_xor(q, 1); q += __shfl_xor(q, 2); q += __shfl_xor(q, 4);
        const float rstd = 1.0f / sqrtf(q * (1.f / 64.f) + GN_EPS); const float bon = bonus[(size_t)n * 8 + h];
        float y[8];
#pragma unroll
        for (int e = 0; e < 8; ++e) { const float vm = v[e] + muv[e] * (vp[e] - v[e]); y[e] = (o[e] * rstd * lg[e] + lb[e] + bon * vm) * g[e]; }
        v4u ov; ov.x = pkbf(y[0], y[1]); ov.y = pkbf(y[2], y[3]); ov.z = pkbf(y[4], y[5]); ov.w = pkbf(y[6], y[7]);
        *(GAS v4u*)(mix + (size_t)n * D + c0) = ov;
    }
}

__global__ void __launch_bounds__(NWAVES * 64, 2) mk_fwd(Args A) {
    extern __shared__ __attribute__((aligned(16))) unsigned char lds_raw[];
    Frame F; F.lds = (LAS unsigned char*)lds_raw; F.tid = threadIdx.x; F.lane = F.tid & 63; F.wave = __builtin_amdgcn_readfirstlane(F.tid >> 6);
    F.G = gridDim.x; F.gw = blockIdx.x * NWAVES + F.wave; F.NGW = F.G * NWAVES;
    volatile LAS unsigned* MISC = (volatile LAS unsigned*)(F.lds + MISC_OFF);
    for (int u = F.tid; u < (LDS_BYTES - MISC_OFF) / 4; u += NWAVES * 64) ((LAS unsigned*)(F.lds + MISC_OFF))[u] = 0u;
    __syncthreads();
    unsigned char* ws = A.ws;
    XcdBarrier bar = xcd_barrier_post((unsigned*)(ws + WS_CTL) + CW_BAR, MISC + 8);
#define GRID_BAR() xcd_barrier(bar)
    bf16* XB = (bf16*)(ws + WS_XB); bf16* HB = (bf16*)(ws + WS_H); bf16* PROJ = (bf16*)(ws + WS_PROJ); bf16* AP = (bf16*)(ws + WS_AP); bf16* MIX = (bf16*)(ws + WS_MIX);
    float* Z = A.out + O_Y;
    LAS unsigned char* ring = F.lds;

#ifndef PHMASK
#define PHMASK 0xFFFF
#endif
#if (PHMASK >> 0) & 1
    phase_prologue(A, F); GRID_BAR();
#endif
#if (PHMASK >> 1) & 1
    { pg8::Gemm g{XB, (const bf16*)(ws + WS_WGU1), M, NGU, D}; pg8::StaticOrder S; S.init(M, NGU, F.G, (int)blockIdx.x); pg8::EpiSwiGLU E{HB, FF};
      pg8::gemm_phase<pg8::EpiSwiGLU, pg8::StaticOrder, true, true>(ring, g, S, E); }
#endif
    GRID_BAR();
#if (PHMASK >> 2) & 1
    { pg8::Gemm g{HB, (const bf16*)(ws + WS_WD1), M, D, FF}; pg8::StaticOrder S; S.init(M, D, F.G, (int)blockIdx.x); pg8::EpiRes<false> E{A.in[I_XP], A.in[I_XS], MP / 256, Z, D, ALPHA, 0.5f};
      pg8::gemm_phase<pg8::EpiRes<false>, pg8::StaticOrder, true, true>(ring, g, S, E); }
#endif
    GRID_BAR();
#if (PHMASK >> 3) & 1
    phase_ln<false>(F, Z, XB, A.in[I_LN1G], A.in[I_LN1B]); GRID_BAR();
#endif
#if (PHMASK >> 4) & 1
    { pg8::Gemm g{XB, (const bf16*)(ws + WS_WIN), M, PTOT, D}; pg8::StaticOrder S; S.init(M, PTOT, F.G, (int)blockIdx.x); pg8::EpiBf16<0> E{PROJ, PTOT, nullptr, 0, 0, 1.f};
      pg8::gemm_phase<pg8::EpiBf16<0>, pg8::StaticOrder, true, true>(ring, g, S, E); }
#endif
    GRID_BAR();
#if (PHMASK >> 5) & 1
    phase_prep(A, F); GRID_BAR();
#endif
#if (PHMASK >> 6) & 1
    { pg8::Gemm g{AP, (const bf16*)(ws + WS_WL), M, NLORA, KLORA}; pg8::StaticOrder S; S.init(M, NLORA, F.G, (int)blockIdx.x);
      pg8::EpiBf16<0> E{(bf16*)A.out, NLORA, nullptr, 0, 0, 1.f};
      pg8::gemm_phase<pg8::EpiBf16<0>, pg8::StaticOrder, true, true>(ring, g, S, E); }
#endif
    GRID_BAR();
#if (PHMASK >> 7) & 1
    phase_recurrence(A, F); GRID_BAR();
#endif
#if (PHMASK >> 8) & 1
    phase_post(A, F); GRID_BAR();
#endif
#if (PHMASK >> 9) & 1
    { pg8::Gemm g{MIX, (const bf16*)(ws + WS_WOUT), M, D, D}; pg8::StaticOrder S; S.init(M, D, F.G, (int)blockIdx.x); pg8::EpiRes<true> E{XB, XB, 1 << 30, Z, D, ALPHA, 1.0f};
      pg8::gemm_phase<pg8::EpiRes<true>, pg8::StaticOrder, true, true>(ring, g, S, E); }
#endif
    GRID_BAR();
#if (PHMASK >> 10) & 1
    phase_ln<false>(F, Z, XB, A.in[I_LN2G], A.in[I_LN2B]); GRID_BAR();
#endif
#if (PHMASK >> 11) & 1
    { pg8::Gemm g{XB, (const bf16*)(ws + WS_WGU2), M, NGU, D}; pg8::StaticOrder S; S.init(M, NGU, F.G, (int)blockIdx.x); pg8::EpiSwiGLU E{HB, FF};
      pg8::gemm_phase<pg8::EpiSwiGLU, pg8::StaticOrder, true, true>(ring, g, S, E); }
#endif
    GRID_BAR();
#if (PHMASK >> 12) & 1
    { pg8::Gemm g{HB, (const bf16*)(ws + WS_WD2), M, D, FF}; pg8::StaticOrder S; S.init(M, D, F.G, (int)blockIdx.x); pg8::EpiRes<true> E{XB, XB, 1 << 30, Z, D, ALPHA, 0.5f};
      pg8::gemm_phase<pg8::EpiRes<true>, pg8::StaticOrder, true, true>(ring, g, S, E); }
#endif
    GRID_BAR();
#if (PHMASK >> 13) & 1
    phase_ln<true>(F, Z, XB, A.in[I_LN3G], A.in[I_LN3B]);
#endif
}

extern "C" void kernel_launch(void* const* d_in, const int* in_sizes, int n_in, void* d_out, int out_size, void* d_ws, size_t ws_size, hipStream_t stream) {
    static int grid = 0;
    if (grid == 0) {
        if (n_in != 31 || out_size != (int)O_END || ws_size < WS_END) { fprintf(stderr, "kernel_launch: unexpected sizes n_in %d out %d ws %zu\n", n_in, out_size, ws_size); grid = -1; return; }
        int dev = 0, cus = 0, per_cu = 0;
        if (hipGetDevice(&dev) != hipSuccess || hipDeviceGetAttribute(&cus, hipDeviceAttributeMultiprocessorCount, dev) != hipSuccess) { grid = -1; return; }
        if (hipFuncSetAttribute((const void*)mk_fwd, hipFuncAttributeMaxDynamicSharedMemorySize, LDS_BYTES) != hipSuccess) { fprintf(stderr, "kernel_launch: hipFuncSetAttribute failed\n"); grid = -1; return; }
        if (hipOccupancyMaxActiveBlocksPerMultiprocessor(&per_cu, (const void*)mk_fwd, NWAVES * 64, LDS_BYTES) != hipSuccess || per_cu < 1) { fprintf(stderr, "kernel_launch: occupancy query says %d\n", per_cu); (void)hipGetLastError(); grid = -1; return; }
        if (cus != 256) { fprintf(stderr, "kernel_launch: built for 256 CUs, found %d\n", cus); grid = -1; return; }
        grid = 256;
    }
    if (grid < 0) return;
    (void)hipMemsetAsync((char*)d_ws + WS_CTL, 0, CTL_ZERO_BYTES, stream);
    Args a{};
    for (int i = 0; i < 31; ++i) a.in[i] = (const float*)d_in[i];
    a.out = (float*)d_out; a.ws = (unsigned char*)d_ws;
    hipLaunchKernelGGL(mk_fwd, dim3(grid), dim3(NWAVES * 64), LDS_BYTES, stream, a);
}
```

```cpp
#include <hip/hip_runtime.h>
#include <cstdio>
#include <cstdint>
namespace pg8 {
#define PG8_LAS __attribute__((address_space(3)))
typedef unsigned short bf16_t;
typedef short bf16x8 __attribute__((ext_vector_type(8)));
typedef float f32x4 __attribute__((ext_vector_type(4)));
typedef unsigned u32x4 __attribute__((ext_vector_type(4)));
constexpr int BM = 256, BK = 64, HALF = 128, HTB = HALF * BK * 2  , STAGE_BYTES = 8 * HTB, NXCD = 8, WGM = 8;

__host__ __device__ __forceinline__ int lds_byte(int r, int c) { const int st = (r >> 4) * 2 + (c >> 5), rr = r & 15, cc = c & 31, ob = rr * 64 + cc * 2; return st * 1024 + (ob ^ (((ob >> 9) & 1) << 5)); }
__host__ __device__ __forceinline__ void stage_rc(int b, int& R, int& C) { const int st = b / 1024, sb = b % 1024, swz = sb ^ (((sb >> 9) & 1) << 5); R = (st >> 1) * 16 + swz / 64; C = (st & 1) * 32 + (swz % 64) / 2; }
__host__ __device__ __forceinline__ int perm32(int rho) { const int n = rho >> 4, i = rho & 15; return 8 * (i >> 2) + 4 * n + (i & 3); }

struct Unit { int pm, pn; };
struct Gemm { const bf16_t* A; const bf16_t* Bt; int M, N, K; };

struct StaticOrder {
    int nM, nN, nwg, G, c;
    __host__ __device__ void init(int M, int N, int G_, int c_) { nM = M / BM; nN = N / BM; nwg = nM * nN; G = G_; c = c_; }
    __host__ __device__ bool next(int i, Unit& u) const {
        const long L = (long)i * G + c; if (L >= nwg) return false;
        int wgid = (int)L; { const int q = nwg / NXCD, r = nwg % NXCD, xcd = wgid % NXCD, off = wgid / NXCD; wgid = (xcd < r ? xcd * (q + 1) : r * (q + 1) + (xcd - r) * q) + off; }
        const int nig = WGM * nN, gid = wgid / nig, fm = gid * WGM, gsz = (nM - fm) < WGM ? (nM - fm) : WGM;
        u.pm = fm + ((wgid % nig) % gsz); u.pn = (wgid % nig) / gsz; return true;
    }
    __device__ __forceinline__ void a_ready(const Unit&) const {}
    __device__ __forceinline__ void done(const Unit&) const {}
};

__device__ __forceinline__ unsigned cvt_pk_bf16(float lo, float hi) { unsigned r; asm volatile("v_cvt_pk_bf16_f32 %0, %1, %2" : "=v"(r) : "v"(lo), "v"(hi)); return r; }
typedef float f32x2 __attribute__((ext_vector_type(2)));
__device__ __forceinline__ f32x2 gelu_pk(f32x2 v) {
    const f32x2 av = __builtin_elementwise_abs(v), d = av * 0.2316418882f + 1.0f;
    f32x2 t; t.x = __builtin_amdgcn_rcpf(d.x); t.y = __builtin_amdgcn_rcpf(d.y);
    f32x2 q = t * 0.5307027145f + (-0.7265760135f); q = q * t + 0.7107068705f; q = q * t + (-0.142248368f); q = q * t + 0.127414796f; q = q * t;
    const f32x2 s = (v * v) * (-0.72134752044f);
    f32x2 e; e.x = __builtin_amdgcn_exp2f(s.x); e.y = __builtin_amdgcn_exp2f(s.y);
    const f32x2 m = v * (q * e), r = v - m;
    f32x2 o; o.x = v.x < 0.f ? m.x : r.x; o.y = v.y < 0.f ? m.y : r.y; return o;
}

__device__ __forceinline__ f32x4 lora_act(f32x4 v, int ty) {
    f32x4 s; s.x = __builtin_amdgcn_rcpf(1.0f + __expf(-v.x)); s.y = __builtin_amdgcn_rcpf(1.0f + __expf(-v.y)); s.z = __builtin_amdgcn_rcpf(1.0f + __expf(-v.z)); s.w = __builtin_amdgcn_rcpf(1.0f + __expf(-v.w));
    if (ty == 0) { s.x = 1.0f - __expf(-0.6065306597126334f * s.x); s.y = 1.0f - __expf(-0.6065306597126334f * s.y); s.z = 1.0f - __expf(-0.6065306597126334f * s.z); s.w = 1.0f - __expf(-0.6065306597126334f * s.w); }
    return s;
}
template <int ACT  > struct EpiBf16 {
    static constexpr bool PERM = true, AFTER_DRAIN = false; static_assert(ACT >= 0 && ACT <= 2, "EpiBf16: ACT is 0 (none), 1 (gelu_pk) or 2 (LoRA: tiles 0,1 -> 1 - decay, 2,3 -> sigmoid, 4,5 -> identity)");
    bf16_t* O; int ldc; const float* bias; int split_cols; size_t split_stride; float scale0;
    __device__ __forceinline__ void operator()(const f32x4 (&acc)[2][2][4][2], const Unit& u, int wr, int wc, int fr, int fq) const {
        const int row0 = u.pm * BM + wr * 64 + fr; int colt = u.pn * BM; bf16_t* base = O;
        float sc = 1.f; if (split_cols) { const int t = colt / split_cols; base += (size_t)t * split_stride; colt -= t * split_cols; if (t == 0) sc = scale0; }
        const int col0 = colt + wc * 32 + 8 * fq, bcol0 = u.pn * BM + wc * 32 + 8 * fq;
        f32x4 bv[2][2];
#pragma unroll
        for (int bj = 0; bj < 2; ++bj)
#pragma unroll
            for (int n = 0; n < 2; ++n) bv[bj][n] = bias ? *(const f32x4*)(bias + bcol0 + bj * HALF + 4 * n) : (f32x4){0.f, 0.f, 0.f, 0.f};
#pragma unroll
        for (int ai = 0; ai < 2; ++ai)
#pragma unroll
            for (int m = 0; m < 4; ++m) { bf16_t* rowp = base + (size_t)(row0 + ai * HALF + m * 16) * ldc + col0;
#pragma unroll
                for (int bj = 0; bj < 2; ++bj) { f32x4 v0 = acc[ai][bj][m][0] + bv[bj][0], v1 = acc[ai][bj][m][1] + bv[bj][1];
                    if (ACT == 2) { const int ty = u.pn >> 1;
                        if (ty < 2) { v0 = lora_act(v0, ty); asm volatile("" : "+v"(v0)); v1 = lora_act(v1, ty); asm volatile("" : "+v"(v1)); } }
                    if (ACT == 1) { f32x2 a = gelu_pk((f32x2){v0[0], v0[1]}), b = gelu_pk((f32x2){v0[2], v0[3]}), c = gelu_pk((f32x2){v1[0], v1[1]}), d = gelu_pk((f32x2){v1[2], v1[3]});
                        v0 = (f32x4){a.x, a.y, b.x, b.y}; v1 = (f32x4){c.x, c.y, d.x, d.y}; }
                    v0 = v0 * sc; v1 = v1 * sc; u32x4 w; w.x = cvt_pk_bf16(v0[0], v0[1]); w.y = cvt_pk_bf16(v0[2], v0[3]); w.z = cvt_pk_bf16(v1[0], v1[1]); w.w = cvt_pk_bf16(v1[2], v1[3]);
                    *(u32x4*)(rowp + bj * HALF) = w; } }
    }
};
template <class Epi, class Sched, bool ALIGN_EPI = false, bool SP2 = false>
__device__ __forceinline__ void gemm_phase(PG8_LAS unsigned char* lds, const Gemm g, const Sched& S, const Epi& E) {
    const int tid = threadIdx.x, wid = __builtin_amdgcn_readfirstlane(tid >> 6), lane = tid & 63, wr = wid >> 2, wc = wid & 3, fr = lane & 15, fq = lane >> 4;
    const int K = g.K, nt = K / BK;
    unsigned voffA[2], voffB[2];
#pragma unroll
    for (int i = 0; i < 2; ++i) { int R, C; stage_rc(tid * 16 + i * 8192, R, C); const int Rb = Epi::PERM ? ((R & ~31) + perm32(R & 31)) : R;
        voffA[i] = (unsigned)(R * K + C) * 2u; voffB[i] = (unsigned)(Rb * K + C) * 2u; }
    const size_t kstep = (size_t)(BK * 2);
    const size_t hstep = (size_t)HALF * K * 2;
    const size_t tstep = 2 * hstep;
    const unsigned ldsw = (unsigned)wid * 1024u;
    const int aoff = lds_byte(wr * 64 + fr, fq * 8), boff = lds_byte(wc * 32 + fr, fq * 8);
#define PG8_SA(b, h) (((b) * 2 + (h)) * HTB)
#define PG8_SB(b, h) ((4 + (b) * 2 + (h)) * HTB)
#define PG8_STAGE(bufoff, gbase, voff) do { _Pragma("unroll") for (int _i = 0; _i < 2; ++_i) \
        __builtin_amdgcn_global_load_lds((const unsigned*)((const char*)(gbase) + (voff)[_i]), (PG8_LAS unsigned*)(lds + (bufoff) + ldsw + _i * 8192), 16, 0, 0); } while (0)
#define PG8_LDA(dst, b, h) do { _Pragma("unroll") for (int m = 0; m < 4; ++m) _Pragma("unroll") for (int k = 0; k < 2; ++k) dst[m][k] = *(const PG8_LAS bf16x8*)(lds + PG8_SA(b, h) + aoff + m * 2048 + k * 1024); } while (0)
#define PG8_LDB(dst, b, h) do { _Pragma("unroll") for (int n = 0; n < 2; ++n) _Pragma("unroll") for (int k = 0; k < 2; ++k) dst[n][k] = *(const PG8_LAS bf16x8*)(lds + PG8_SB(b, h) + boff + n * 2048 + k * 1024); } while (0)
#define PG8_MMA(ai, bj, At, Bt) do { __builtin_amdgcn_s_setprio(1); _Pragma("unroll") for (int m = 0; m < 4; ++m) _Pragma("unroll") for (int n = 0; n < 2; ++n) _Pragma("unroll") for (int k = 0; k < 2; ++k) \
        acc[ai][bj][m][n] = __builtin_amdgcn_mfma_f32_16x16x32_bf16(Bt[n][k], At[m][k], acc[ai][bj][m][n], 0, 0, 0); __builtin_amdgcn_s_setprio(0); } while (0)
#define PG8_WAIT_V(n) asm volatile("s_waitcnt vmcnt(" #n ")" ::: "memory")
#define PG8_WAIT_L(n) asm volatile("s_waitcnt lgkmcnt(" #n ")" ::: "memory")
#define PG8_BAR __builtin_amdgcn_s_barrier()
#define PG8_SCHED __builtin_amdgcn_sched_barrier(0)
    Unit cur, nxt; int ui = 0;
    if (!S.next(0, cur)) return;
    f32x4 acc[2][2][4][2];
#pragma unroll
    for (int a = 0; a < 2; ++a)
#pragma unroll
        for (int b = 0; b < 2; ++b)
#pragma unroll
            for (int m = 0; m < 4; ++m)
#pragma unroll
                for (int n = 0; n < 2; ++n) acc[a][b][m][n] = (f32x4){0.f, 0.f, 0.f, 0.f};
    bf16x8 At[4][2], B0[2][2], B1[2][2];
    const char* cA = (const char*)g.A + (size_t)cur.pm * tstep; const char* cB = (const char*)g.Bt + (size_t)cur.pn * tstep;
    S.a_ready(cur);
    if constexpr (SP2) {
        PG8_STAGE(PG8_SB(0, 0), cB, voffB); PG8_STAGE(PG8_SB(0, 1), cB + hstep, voffB); PG8_STAGE(PG8_SA(0, 0), cA, voffA); PG8_STAGE(PG8_SA(0, 1), cA + hstep, voffA);
        if (wr == 1) PG8_BAR;
        PG8_WAIT_V(2); PG8_BAR;
        PG8_STAGE(PG8_SB(1, 0), cB + kstep, voffB); PG8_STAGE(PG8_SA(1, 0), cA + kstep, voffA); PG8_STAGE(PG8_SB(1, 1), cB + hstep + kstep, voffB);
        PG8_WAIT_V(6); PG8_BAR;
    } else {
        PG8_STAGE(PG8_SB(0, 0), cB, voffB); PG8_STAGE(PG8_SA(0, 0), cA, voffA); PG8_STAGE(PG8_SB(0, 1), cB + hstep, voffB); PG8_STAGE(PG8_SA(0, 1), cA + hstep, voffA);
        if (wr == 1) PG8_BAR;
        PG8_WAIT_V(4); PG8_BAR;
        PG8_STAGE(PG8_SB(1, 0), cB + kstep, voffB); PG8_STAGE(PG8_SA(1, 0), cA + kstep, voffA); PG8_STAGE(PG8_SB(1, 1), cB + hstep + kstep, voffB);
        PG8_WAIT_V(6); PG8_BAR;
    }
    for (;;) {
        const bool has_next = S.next(ui + 1, nxt);
        const char* nA = has_next ? (const char*)g.A + (size_t)nxt.pm * tstep : cA; const char* nB = has_next ? (const char*)g.Bt + (size_t)nxt.pn * tstep : cB;
        for (int t = 0; t < nt; t += 2) {
            const bool last = (t == nt - 2);
            const char* a1 = cA + (size_t)(t + 1) * kstep;
            const char* a2 = last ? nA : cA + (size_t)(t + 2) * kstep; const char* b2 = last ? nB : cB + (size_t)(t + 2) * kstep;
            const char* a3 = a2 + kstep; const char* b3 = b2 + kstep;
            if (last && has_next) S.a_ready(nxt);
            if constexpr (SP2) {
            PG8_LDB(B0, 0, 0); PG8_LDB(B1, 0, 1); PG8_SCHED; PG8_LDA(At, 0, 0); PG8_STAGE(PG8_SA(1, 1), a1 + hstep, voffA);
            PG8_WAIT_V(8); PG8_WAIT_L(0); PG8_BAR; PG8_MMA(0, 0, At, B0); PG8_MMA(0, 1, At, B1); PG8_BAR; PG8_SCHED;
            PG8_LDA(At, 0, 1); PG8_STAGE(PG8_SB(0, 0), b2, voffB); PG8_STAGE(PG8_SB(0, 1), b2 + hstep, voffB); PG8_STAGE(PG8_SA(0, 0), a2, voffA);
            PG8_WAIT_V(8); PG8_WAIT_L(0); PG8_BAR; PG8_MMA(1, 0, At, B0); PG8_MMA(1, 1, At, B1); PG8_BAR; PG8_SCHED;
            PG8_LDB(B0, 1, 0); PG8_LDB(B1, 1, 1); PG8_SCHED; PG8_LDA(At, 1, 0); PG8_STAGE(PG8_SA(0, 1), a2 + hstep, voffA);
            PG8_WAIT_V(8); PG8_WAIT_L(0); PG8_BAR; PG8_MMA(0, 0, At, B0); PG8_MMA(0, 1, At, B1); PG8_BAR; PG8_SCHED;
            PG8_LDA(At, 1, 1); PG8_STAGE(PG8_SB(1, 0), b3, voffB); PG8_STAGE(PG8_SB(1, 1), b3 + hstep, voffB); PG8_STAGE(PG8_SA(1, 0), a3, voffA);
            PG8_WAIT_V(8); PG8_WAIT_L(0); PG8_BAR; PG8_MMA(1, 0, At, B0); PG8_MMA(1, 1, At, B1); PG8_BAR; PG8_SCHED;
            } else {
            PG8_LDB(B0, 0, 0); PG8_SCHED; PG8_LDA(At, 0, 0); PG8_STAGE(PG8_SA(1, 1), a1 + hstep, voffA);
            PG8_WAIT_L(8); PG8_BAR; PG8_WAIT_L(0); PG8_MMA(0, 0, At, B0); PG8_BAR; PG8_SCHED;
            PG8_LDB(B1, 0, 1); PG8_STAGE(PG8_SB(0, 0), b2, voffB);
            PG8_BAR; PG8_WAIT_L(0); PG8_MMA(0, 1, At, B1); PG8_BAR;
            PG8_LDA(At, 0, 1); PG8_STAGE(PG8_SA(0, 0), a2, voffA);
            PG8_BAR; PG8_WAIT_L(0); PG8_MMA(1, 0, At, B0); PG8_BAR; PG8_SCHED;
            PG8_STAGE(PG8_SB(0, 1), b2 + hstep, voffB);
            PG8_WAIT_V(6); PG8_BAR; PG8_MMA(1, 1, At, B1); PG8_BAR;
            PG8_LDB(B0, 1, 0); PG8_SCHED; PG8_LDA(At, 1, 0); PG8_STAGE(PG8_SA(0, 1), a2 + hstep, voffA);
            PG8_WAIT_L(8); PG8_BAR; PG8_WAIT_L(0); PG8_MMA(0, 0, At, B0); PG8_BAR; PG8_SCHED;
            PG8_LDB(B1, 1, 1); PG8_STAGE(PG8_SB(1, 0), b3, voffB);
            PG8_BAR; PG8_WAIT_L(0); PG8_MMA(0, 1, At, B1); PG8_BAR;
            PG8_LDA(At, 1, 1); PG8_STAGE(PG8_SA(1, 0), a3, voffA);
            PG8_BAR; PG8_WAIT_L(0); PG8_MMA(1, 0, At, B0); PG8_BAR; PG8_SCHED;
            PG8_STAGE(PG8_SB(1, 1), b3 + hstep, voffB);
            PG8_WAIT_V(6); PG8_BAR; PG8_MMA(1, 1, At, B1); PG8_BAR;
            }
        }
        if constexpr (ALIGN_EPI) { if (wr == 0) PG8_BAR; }
        if constexpr (!Epi::AFTER_DRAIN) { E(acc, cur, wr, wc, fr, fq); S.done(cur); }
        if (!has_next) break;
#pragma unroll
        for (int a = 0; a < 2; ++a)
#pragma unroll
            for (int b = 0; b < 2; ++b)
#pragma unroll
                for (int m = 0; m < 4; ++m)
#pragma unroll
                    for (int n = 0; n < 2; ++n) acc[a][b][m][n] = (f32x4){0.f, 0.f, 0.f, 0.f};
        cur = nxt; cA = nA; cB = nB; ++ui;
        if constexpr (ALIGN_EPI) { if (wr == 1) PG8_BAR; }
    }
    PG8_WAIT_V(0);
    if constexpr (!ALIGN_EPI) { if (wr == 0) PG8_BAR; }
    PG8_BAR;
    if constexpr (Epi::AFTER_DRAIN) { E.fused(acc, cur, wr, wc, fr, fq, lds, wid, lane); S.done(cur); }
#undef PG8_SA
#undef PG8_SB
#undef PG8_STAGE
#undef PG8_LDA
#undef PG8_LDB
#undef PG8_MMA
#undef PG8_WAIT_V
#undef PG8_WAIT_L
#undef PG8_BAR
#undef PG8_SCHED
}
}
#define GAS __attribute__((address_space(1)))
#define LAS __attribute__((address_space(3)))
typedef unsigned short bf16;
typedef unsigned v4u __attribute__((ext_vector_type(4)));
typedef float f32x4 __attribute__((ext_vector_type(4)));
typedef short bf16x8 __attribute__((ext_vector_type(8)));
typedef GAS unsigned gu32;
typedef GAS unsigned long long gu64;
#define RLX_AGENT __ATOMIC_RELAXED, __HIP_MEMORY_SCOPE_AGENT
#define LDS_WAIT() asm volatile("s_waitcnt lgkmcnt(0)" ::: "memory")
#define VM_WAIT() asm volatile("s_waitcnt vmcnt(0)" ::: "memory")
__device__ __forceinline__ unsigned long long rt() { return __builtin_amdgcn_s_memrealtime(); }
__device__ __forceinline__ unsigned f2bf(float f) { unsigned u = __builtin_bit_cast(unsigned, f); return (u + 0x7fffu + ((u >> 16) & 1u)) >> 16; }
__device__ __forceinline__ unsigned pk2(float lo, float hi) { return f2bf(lo) | (f2bf(hi) << 16); }

#define XB_TMO      128
#define XB_XCNT(j)  (256  + 64 * (j))
#define XB_XSUB(j)  (1280 + 64 * (j))
#define XB_XGEN(j)  (2304 + 64 * (j))
#define XB_TOP      3328
#define XB_TOPGEN   3392
#define XCD_BAR_WORDS 3456
#define XB_SPIN_CAP (1u << 18)

__device__ __forceinline__ unsigned xb_ld(unsigned* p)              { return __hip_atomic_load(p, __ATOMIC_RELAXED, __HIP_MEMORY_SCOPE_AGENT); }
__device__ __forceinline__ unsigned xb_add(unsigned* p, unsigned v) { return __hip_atomic_fetch_add(p, v, __ATOMIC_RELAXED, __HIP_MEMORY_SCOPE_AGENT); }
__device__ __forceinline__ unsigned xb_xcc_id() { return (unsigned)__builtin_amdgcn_s_getreg((3 << 11) | 20) & 0xFu; }
#define XB_SPIN(cond, bar) do { unsigned _sp = 0; while (cond) { __builtin_amdgcn_s_sleep(1); \
    if ((++_sp & 255u) == 0u) { if (xb_ld(&(bar)[XB_TMO])) break; if (_sp > XB_SPIN_CAP) { atomicAdd(&(bar)[XB_TMO], 1u); break; } } } } while (0)

struct XcdBarrier {
    unsigned* bar; unsigned x;
    volatile LAS unsigned* st;
};

__device__ __forceinline__ XcdBarrier xcd_barrier_post(unsigned* bar, volatile LAS unsigned* st) {
    XcdBarrier b; b.bar = bar; b.x = xb_xcc_id(); b.st = st;
    if (threadIdx.x == 0) (void)xb_add(&bar[XB_XCNT(b.x)], 1u);
    return b;
}
__device__ __forceinline__ void xcd_barrier_complete(unsigned* bar, unsigned x, unsigned& nloc, unsigned& nx) {
    const unsigned G = gridDim.x * gridDim.y * gridDim.z;
    unsigned sum, cnt, mine, sp = 0u;
    for (;;) {
        sum = 0u; cnt = 0u; mine = 0u;
#pragma unroll
        for (unsigned j = 0; j < 16; ++j) { const unsigned c = xb_ld(&bar[XB_XCNT(j)]); sum += c; cnt += (c > 0u) ? 1u : 0u; mine = (j == x) ? c : mine; }
        if (sum == G) break;
        __builtin_amdgcn_s_sleep(1);
        if ((++sp & 255u) == 0u) { if (xb_ld(&bar[XB_TMO])) break; if (sp > XB_SPIN_CAP) { atomicAdd(&bar[XB_TMO], 1u); break; } }
    }
    nloc = mine > 0u ? mine : 1u; nx = cnt > 0u ? cnt : 1u;
}

__device__ __forceinline__ void xcd_barrier(const XcdBarrier& b) {
    asm volatile("s_waitcnt vmcnt(0)" ::: "memory");
    __syncthreads();
    if (threadIdx.x == 0) {
        unsigned* bar = b.bar;
        __builtin_amdgcn_s_waitcnt(0);
        unsigned nloc = b.st[0], nx = b.st[1];
        if (nloc == 0u) { xcd_barrier_complete(bar, b.x, nloc, nx); b.st[0] = nloc; b.st[1] = nx; }
        const unsigned old = xb_add(&bar[XB_XSUB(b.x)], 1u);
        const unsigned gen = old / nloc;
        if (old + 1u == (gen + 1u) * nloc) {
            __builtin_amdgcn_fence(__ATOMIC_RELEASE, "agent");
            asm volatile("s_waitcnt vmcnt(0)" ::: "memory");
            const unsigned og = xb_add(&bar[XB_TOP], 1u);
            const unsigned tg = og / nx;
            if (og + 1u == (tg + 1u) * nx) xb_add(&bar[XB_TOPGEN], 1u);
            else XB_SPIN(xb_ld(&bar[XB_TOPGEN]) == tg, bar);
            __builtin_amdgcn_fence(__ATOMIC_ACQUIRE, "agent");
            xb_add(&bar[XB_XGEN(b.x)], 1u);
            asm volatile("s_waitcnt vmcnt(0)" ::: "memory");
        } else {
            XB_SPIN(xb_ld(&bar[XB_XGEN(b.x)]) == gen, bar);
            __builtin_amdgcn_fence(__ATOMIC_ACQUIRE, "agent");
            asm volatile("s_waitcnt vmcnt(0)" ::: "memory");
        }
    }
    __syncthreads();
}

constexpr int NWAVES = 8;
constexpr int D = 1024, FF = 2816, MP = 16384, MS = 512, M = MP + MS;
constexpr int PSH = 1792, PTOT = 3328, OFF_V = 1024, OFF_WD = 1536, OFF_CB = 1792, OFF_CC = 2304, OFF_CH = 2816;
constexpr int NH = 8, DR = 512;
constexpr int NGU = 2 * FF;
constexpr int NLORA = 1536, KLORA = 256;
constexpr float ALPHA = 1.189207115002721f;
constexpr float LN_EPS = 1e-5f, GN_EPS = 64e-5f;
constexpr size_t O_Y = 0, O_WKVP = (size_t)M * D, O_SHP = O_WKVP + 8 * 8 * 4096, O_CVP = O_SHP + 8 * PSH, O_WKVS = O_CVP + 8 * 2 * 512,
                 O_SHS = O_WKVS + (size_t)128 * 8 * 4096, O_CVS = O_SHS + 128 * PSH, O_END = O_CVS + 128 * 2 * 512;
constexpr size_t MiB = 1u << 20;
constexpr size_t WS_CTL = 0, CTL_ZERO_BYTES = 64 * 1024;
constexpr size_t WS_WGU1 = 1 * MiB, WS_WD1 = 12 * MiB, WS_WGU2 = 18 * MiB, WS_WD2 = 29 * MiB, WS_WIN = 35 * MiB, WS_WOUT = 42 * MiB, WS_WL = 44 * MiB;
constexpr size_t WS_XB = 45 * MiB;
constexpr size_t WS_BONUS = 78 * MiB;
constexpr size_t WS_LBIAS = 78 * MiB + 768 * 1024;
constexpr size_t WS_H = 79 * MiB;
constexpr size_t WS_PROJ = 79 * MiB;
constexpr size_t WS_AP = 187 * MiB;
constexpr size_t WS_MIX = 196 * MiB;
constexpr size_t WS_END = 230 * MiB;
constexpr int CW_BAR = 1024;
static_assert((CW_BAR + XCD_BAR_WORDS) * 4 <= (int)CTL_ZERO_BYTES, "ctl");
constexpr int RING_BYTES = 131072, MISC_OFF = 143360, LDS_BYTES = 147456;

__device__ __forceinline__ float bf2f(unsigned short b) { return __builtin_bit_cast(float, (unsigned)b << 16); }
__device__ __forceinline__ float bflo(unsigned w) { return __builtin_bit_cast(float, w << 16); }
__device__ __forceinline__ float bfhi(unsigned w) { return __builtin_bit_cast(float, w & 0xffff0000u); }
__device__ __forceinline__ unsigned pkbf(float lo, float hi) { return pg8::cvt_pk_bf16(lo, hi); }
__device__ __forceinline__ float wave_sum(float v) {
#pragma unroll
    for (int o = 1; o < 64; o <<= 1) v += __shfl_xor(v, o);
    return v;
}
__device__ __forceinline__ float sigmoidf_(float x) { return __builtin_amdgcn_rcpf(1.0f + __expf(-x)); }

struct Args { const float* in[31]; float* out; unsigned char* ws; };
enum { I_XP = 0, I_XS, I_SWKV, I_SSH, I_SCV, I_LN1G, I_LN1B, I_F1G, I_F1U, I_F1D, I_WIN, I_MU, I_W0, I_WLU, I_A0, I_ALU, I_GLU, I_KK, I_KA, I_RK, I_LNXG, I_LNXB, I_CW, I_WOUT,
       I_LN2G, I_LN2B, I_F2G, I_F2U, I_F2D, I_LN3G, I_LN3B };

namespace pg8 {
struct EpiSwiGLU {
    static constexpr bool PERM = true, AFTER_DRAIN = false;
    bf16_t* O; int ldc;
    __device__ __forceinline__ void operator()(const f32x4 (&acc)[2][2][4][2], const Unit& u, int wr, int wc, int fr, int fq) const {
        const int row0 = u.pm * BM + wr * 64 + fr, col0 = u.pn * 128 + wc * 32 + 8 * fq;
#pragma unroll
        for (int ai = 0; ai < 2; ++ai)
#pragma unroll
            for (int m = 0; m < 4; ++m) { bf16_t* rowp = O + (size_t)(row0 + ai * HALF + m * 16) * ldc + col0; float hv[8];
#pragma unroll
                for (int n = 0; n < 2; ++n)
#pragma unroll
                    for (int e = 0; e < 4; ++e) { const float g = acc[ai][0][m][n][e], up = acc[ai][1][m][n][e]; hv[n * 4 + e] = g * __builtin_amdgcn_rcpf(1.0f + __expf(-g)) * up; }
                u32x4 w; w.x = cvt_pk_bf16(hv[0], hv[1]); w.y = cvt_pk_bf16(hv[2], hv[3]); w.z = cvt_pk_bf16(hv[4], hv[5]); w.w = cvt_pk_bf16(hv[6], hv[7]);
                *(u32x4*)rowp = w; }
    }
};
struct EpiLoraAct {
    static constexpr bool PERM = true, AFTER_DRAIN = false;
    bf16_t* O; const float* bias;
    __device__ __forceinline__ void operator()(const f32x4 (&acc)[2][2][4][2], const Unit& u, int wr, int wc, int fr, int fq) const {
        const int row0 = u.pm * BM + wr * 64 + fr, col0 = u.pn * BM + wc * 32 + 8 * fq, ty = u.pn >> 1;
#pragma unroll
        for (int bj = 0; bj < 2; ++bj) {
            const f32x4 b0 = *(const f32x4*)(bias + col0 + bj * HALF), b1 = *(const f32x4*)(bias + col0 + bj * HALF + 4);
#pragma unroll
            for (int ai = 0; ai < 2; ++ai)
#pragma unroll
                for (int m = 0; m < 4; ++m) { f32x4 v0 = acc[ai][bj][m][0] + b0, v1 = acc[ai][bj][m][1] + b1;
                    if (ty < 2) { v0 = lora_act(v0, ty); v1 = lora_act(v1, ty); }
                    u32x4 w; w.x = cvt_pk_bf16(v0.x, v0.y); w.y = cvt_pk_bf16(v0.z, v0.w); w.z = cvt_pk_bf16(v1.x, v1.y); w.w = cvt_pk_bf16(v1.z, v1.w);
                    *(u32x4*)(O + (size_t)(row0 + ai * HALF + m * 16) * 1536 + col0 + bj * HALF) = w;
                    asm volatile("" ::: "memory"); } }
    }
};
template <bool RES_BF16> struct EpiRes {
    static constexpr bool PERM = false, AFTER_DRAIN = false;
    const void* r0; const void* r1; int split_pm; float* out; int ldc; float alpha, beta;
    __device__ __forceinline__ void operator()(const f32x4 (&acc)[2][2][4][2], const Unit& u, int wr, int wc, int fr, int fq) const {
        const int col0 = u.pn * BM + wc * 32 + 4 * fq;
        const char* rb = (const char*)(u.pm < split_pm ? r0 : r1); const int rrow0 = (u.pm < split_pm ? u.pm : u.pm - split_pm) * BM;
#pragma unroll
        for (int ai = 0; ai < 2; ++ai)
#pragma unroll
            for (int m = 0; m < 4; ++m) { const int rl = ai * HALF + wr * 64 + m * 16 + fr; const size_t off = (size_t)(u.pm * BM + rl) * ldc + col0; const size_t roff = (size_t)(rrow0 + rl) * ldc + col0;
#pragma unroll
                for (int bj = 0; bj < 2; ++bj)
#pragma unroll
                    for (int n = 0; n < 2; ++n) { f32x4 rv;
                        if (RES_BF16) { typedef unsigned u32x2v __attribute__((ext_vector_type(2))); const u32x2v w = *(const u32x2v*)(rb + (roff + bj * HALF + n * 16) * 2);
                            rv = (f32x4){__builtin_bit_cast(float, w.x << 16), __builtin_bit_cast(float, w.x & 0xffff0000u), __builtin_bit_cast(float, w.y << 16), __builtin_bit_cast(float, w.y & 0xffff0000u)}; }
                        else rv = *(const f32x4*)(rb + (roff + bj * HALF + n * 16) * 4);
                        *(f32x4*)(out + off + bj * HALF + n * 16) = rv * alpha + acc[ai][bj][m][n] * beta; } }
    }
};
}

struct Frame {
    LAS unsigned char* lds; int tid, lane, wave, gw, NGW, G;
};

__device__ __forceinline__ void p0_transpose_item(const float* W, int N, bf16* WT, int ldt, int coff, int drow0, LAS float* scr, int k0, int n0, int lane) {
#pragma unroll 8
    for (int i = 0; i < 32; ++i) { const int kk = 2 * i + (lane >> 5); scr[kk * 33 + (lane & 31)] = W[(size_t)(k0 + kk) * N + n0 + (lane & 31)]; }
    LDS_WAIT(); asm volatile("" ::: "memory");
    const int c = lane & 7;
#pragma unroll
    for (int j = 0; j < 4; ++j) { const int n = (lane >> 3) + 8 * j; const LAS float* s = scr + (8 * c) * 33 + n;
        v4u o; o.x = pkbf(s[0 * 33], s[1 * 33]); o.y = pkbf(s[2 * 33], s[3 * 33]); o.z = pkbf(s[4 * 33], s[5 * 33]); o.w = pkbf(s[6 * 33], s[7 * 33]);
        *(GAS v4u*)(WT + (size_t)(drow0 + n) * ldt + coff + k0 + 8 * c) = o; }
    LDS_WAIT(); asm volatile("" ::: "memory");
}

__device__ __forceinline__ void phase_prologue(const Args& A, Frame& F) {
    unsigned char* ws = A.ws;
    LAS float* scr = (LAS float*)(F.lds + F.wave * 16384);
    constexpr int I_GU = 16 * 88, I_DN = 44 * 32, I_IN = 16 * 104, I_OUT = 16 * 32, I_L64 = 16, I_L128 = 32;
    constexpr int NITEMS = 6 * I_GU + I_IN + I_OUT + 2 * I_L64 + I_L128;
    static_assert(I_GU == I_DN, "");
    for (int it = F.gw; it < NITEMS; it += F.NGW) {
        int r = it;
        if (r < 6 * I_GU) { const int mtx = r / I_GU; r -= mtx * I_GU; const int f2 = mtx >= 3, kind = mtx % 3;
            if (kind < 2) { const int nblk = FF / 32, kb = r / nblk, nb = r % nblk, n0 = nb * 32; const int drow = (n0 >> 7) * 256 + (n0 & 127) + kind * 128;
                p0_transpose_item(A.in[(f2 ? I_F2G : I_F1G) + kind], FF, (bf16*)(ws + (f2 ? WS_WGU2 : WS_WGU1)), D, 0, drow, scr, kb * 64, n0, F.lane); }
            else { const int nblk = D / 32, kb = r / nblk, nb = r % nblk;
                p0_transpose_item(A.in[f2 ? I_F2D : I_F1D], D, (bf16*)(ws + (f2 ? WS_WD2 : WS_WD1)), FF, 0, nb * 32, scr, kb * 64, nb * 32, F.lane); }
            continue; }
        r -= 6 * I_GU;
        if (r < I_IN) { const int nblk = PTOT / 32, kb = r / nblk, nb = r % nblk; p0_transpose_item(A.in[I_WIN], PTOT, (bf16*)(ws + WS_WIN), D, 0, nb * 32, scr, kb * 64, nb * 32, F.lane); continue; }
        r -= I_IN;
        if (r < I_OUT) { const int nblk = D / 32, kb = r / nblk, nb = r % nblk; p0_transpose_item(A.in[I_WOUT], D, (bf16*)(ws + WS_WOUT), D, 0, nb * 32, scr, kb * 64, nb * 32, F.lane); continue; }
        r -= I_OUT;
        if (r < I_L64) { p0_transpose_item(A.in[I_WLU], 512, (bf16*)(ws + WS_WL), KLORA, 0, r * 32, scr, 0, r * 32, F.lane); continue; }
        r -= I_L64;
        if (r < I_L64) { p0_transpose_item(A.in[I_ALU], 512, (bf16*)(ws + WS_WL), KLORA, 64, 512 + r * 32, scr, 0, r * 32, F.lane); continue; }
        r -= I_L64;
        { const int kb = r / 16, nb = r % 16; p0_transpose_item(A.in[I_GLU], 512, (bf16*)(ws + WS_WL), KLORA, 128, 1024 + nb * 32, scr, kb * 64, nb * 32, F.lane); }
    }
    { const int gt = F.gw * 64 + F.lane, NT = F.NGW * 64;
      for (int ch = gt; ch < NLORA * KLORA / 8; ch += NT) { const int row = ch >> 5, col = (ch & 31) * 8; const int ty = row >> 9;
          const bool nz = ty == 0 ? (col < 64) : (ty == 1 ? (col >= 64 && col < 128) : (col >= 128));
          if (!nz) *(GAS v4u*)((bf16*)(ws + WS_WL) + (size_t)row * KLORA + col) = (v4u){0u, 0u, 0u, 0u}; } }
    { const int gt = F.gw * 64 + F.lane; if (gt < NLORA) ((float*)(ws + WS_LBIAS))[gt] = gt < 512 ? A.in[I_W0][gt] : (gt < 1024 ? A.in[I_A0][gt - 512] : 0.f); }
    for (int m = F.gw; m < M; m += F.NGW) {
        const float* xrow = m < MP ? A.in[I_XP] + (size_t)m * D : A.in[I_XS] + (size_t)(m - MP) * D;
        const GAS f32x4* xr = (const GAS f32x4*)xrow + F.lane; GAS unsigned long long* o8 = (GAS unsigned long long*)((bf16*)(ws + WS_XB) + (size_t)m * D) + F.lane;
#pragma unroll
        for (int j = 0; j < 4; ++j) { const f32x4 v = xr[64 * j]; o8[64 * j] = (unsigned long long)pkbf(v.x, v.y) | ((unsigned long long)pkbf(v.z, v.w) << 32); }
    }
}

template <bool FINAL> __device__ __forceinline__ void phase_ln(Frame& F, float* z, bf16* xb, const float* g, const float* b) {
    f32x4 gv[4], bv[4];
#pragma unroll
    for (int j = 0; j < 4; ++j) { gv[j] = ((const GAS f32x4*)g)[F.lane + 64 * j]; bv[j] = ((const GAS f32x4*)b)[F.lane + 64 * j]; }
    for (int m = F.gw; m < M; m += F.NGW) {
        GAS f32x4* xr = (GAS f32x4*)(z + (size_t)m * D) + F.lane;
        f32x4 v[4]; float s = 0.f;
#pragma unroll
        for (int j = 0; j < 4; ++j) { v[j] = xr[64 * j]; s += (v[j].x + v[j].y) + (v[j].z + v[j].w); }
        const float mean = wave_sum(s) * (1.f / D); float s2 = 0.f;
#pragma unroll
        for (int j = 0; j < 4; ++j) { v[j] = v[j] - mean; s2 += (v[j].x * v[j].x + v[j].y * v[j].y) + (v[j].z * v[j].z + v[j].w * v[j].w); }
        const float rstd = 1.f / sqrtf(wave_sum(s2) * (1.f / D) + LN_EPS);
        if (FINAL) {
#pragma unroll
            for (int j = 0; j < 4; ++j) xr[64 * j] = v[j] * rstd * gv[j] + bv[j];
        } else {
            GAS unsigned long long* o8 = (GAS unsigned long long*)(xb + (size_t)m * D) + F.lane;
#pragma unroll
            for (int j = 0; j < 4; ++j) { const f32x4 o = v[j] * rstd * gv[j] + bv[j]; o8[64 * j] = (unsigned long long)pkbf(o.x, o.y) | ((unsigned long long)pkbf(o.z, o.w) << 32); }
        }
    }
}

struct Tok { int s, t, T; bool prompt; };
__device__ __forceinline__ Tok tok_of(int n) { Tok k; k.prompt = n < MP; if (k.prompt) { k.s = n >> 11; k.t = n & 2047; k.T = 2048; } else { const int r = n - MP; k.s = r >> 2; k.t = r & 3; k.T = 4; } return k; }

__device__ __forceinline__ void phase_prep(const Args& A, Frame& F) {
    unsigned char* ws = A.ws; const bf16* proj = (const bf16*)(ws + WS_PROJ); bf16* ap = (bf16*)(ws + WS_AP); bf16* mix = (bf16*)(ws + WS_MIX);
    const int lane = F.lane;
    const f32x4 mu4 = *(const GAS f32x4*)(A.in[I_MU] + OFF_WD + 4 * lane);
    float cw[3][8];
#pragma unroll
    for (int i = 0; i < 3; ++i)
#pragma unroll
        for (int e = 0; e < 8; ++e) cw[i][e] = A.in[I_CW][i * 512 + 8 * lane + e];
    typedef unsigned u32x2v __attribute__((ext_vector_type(2)));
    for (int n = F.gw; n < M; n += F.NGW) {
        const Tok k = tok_of(n); const bf16* pr = proj + (size_t)n * PTOT;
        { const u32x2v c = *(const GAS u32x2v*)(pr + OFF_WD + 4 * lane); f32x4 cur = (f32x4){bflo(c.x), bfhi(c.x), bflo(c.y), bfhi(c.y)}, prev;
          if (k.t > 0) { const u32x2v p = *(const GAS u32x2v*)(pr - PTOT + OFF_WD + 4 * lane); prev = (f32x4){bflo(p.x), bfhi(p.x), bflo(p.y), bfhi(p.y)}; }
          else if (!k.prompt) prev = *(const GAS f32x4*)(A.in[I_SSH] + (size_t)k.s * PSH + OFF_WD + 4 * lane);
          else prev = (f32x4){0.f, 0.f, 0.f, 0.f};
          f32x4 m = cur + mu4 * (prev - cur);
          if (lane < 16) { m.x = tanhf(m.x); m.y = tanhf(m.y); m.z = tanhf(m.z); m.w = tanhf(m.w); }
          else if (lane >= 32) { m.x = sigmoidf_(m.x); m.y = sigmoidf_(m.y); m.z = sigmoidf_(m.z); m.w = sigmoidf_(m.w); }
          u32x2v o; o.x = pkbf(m.x, m.y); o.y = pkbf(m.z, m.w); *(GAS u32x2v*)(ap + (size_t)n * KLORA + 4 * lane) = o; }
        { const v4u cbw = *(const GAS v4u*)(pr + OFF_CB + 8 * lane), ccw = *(const GAS v4u*)(pr + OFF_CC + 8 * lane), chw = *(const GAS v4u*)(pr + OFF_CH + 8 * lane);
          float u2[8], u1[8], u0[8], cb[8];
#pragma unroll
          for (int e = 0; e < 4; ++e) { u2[2 * e] = bflo(ccw[e]) * bflo(chw[e]); u2[2 * e + 1] = bfhi(ccw[e]) * bfhi(chw[e]); cb[2 * e] = bflo(cbw[e]); cb[2 * e + 1] = bfhi(cbw[e]); }
          const float* sc = A.in[I_SCV] + (size_t)k.s * 1024 + 8 * lane;
          if (k.t >= 1) { const v4u a = *(const GAS v4u*)(pr - PTOT + OFF_CC + 8 * lane), b = *(const GAS v4u*)(pr - PTOT + OFF_CH + 8 * lane);
#pragma unroll
              for (int e = 0; e < 4; ++e) { u1[2 * e] = bflo(a[e]) * bflo(b[e]); u1[2 * e + 1] = bfhi(a[e]) * bfhi(b[e]); } }
          else {
#pragma unroll
              for (int e = 0; e < 8; ++e) u1[e] = k.prompt ? 0.f : sc[512 + e]; }
          if (k.t >= 2) { const v4u a = *(const GAS v4u*)(pr - 2 * PTOT + OFF_CC + 8 * lane), b = *(const GAS v4u*)(pr - 2 * PTOT + OFF_CH + 8 * lane);
#pragma unroll
              for (int e = 0; e < 4; ++e) { u0[2 * e] = bflo(a[e]) * bflo(b[e]); u0[2 * e + 1] = bfhi(a[e]) * bfhi(b[e]); } }
          else {
#pragma unroll
              for (int e = 0; e < 8; ++e) u0[e] = k.prompt ? 0.f : sc[k.t * 512 + e]; }
          float y[8];
#pragma unroll
          for (int e = 0; e < 8; ++e) y[e] = cb[e] * (cw[0][e] * u0[e] + cw[1][e] * u1[e] + cw[2][e] * u2[e]);
          v4u o; o.x = pkbf(y[0], y[1]); o.y = pkbf(y[2], y[3]); o.z = pkbf(y[4], y[5]); o.w = pkbf(y[6], y[7]);
          *(GAS v4u*)(mix + (size_t)n * D + 512 + 8 * lane) = o;
          if (k.t >= k.T - 2) { float* co = A.out + (k.prompt ? O_CVP : O_CVS) + ((size_t)k.s * 2 + (k.t - (k.T - 2))) * 512 + 8 * lane;
              *(GAS f32x4*)co = (f32x4){u2[0], u2[1], u2[2], u2[3]}; *(GAS f32x4*)(co + 4) = (f32x4){u2[4], u2[5], u2[6], u2[7]}; } }
        if (k.t == k.T - 1) { float* so = A.out + (k.prompt ? O_SHP : O_SHS) + (size_t)k.s * PSH;
#pragma unroll
            for (int i = 0; i < 7; ++i) { const u32x2v c = *(const GAS u32x2v*)(pr + 256 * i + 4 * lane); *(GAS f32x4*)(so + 256 * i + 4 * lane) = (f32x4){bflo(c.x), bfhi(c.x), bflo(c.y), bfhi(c.y)}; } }
    }
}

constexpr int TC = 32, RB_TOK = 320, RB_VT = TC * RB_TOK, VT_LD = 36, RB_FLOATS = RB_VT + 64 * VT_LD;
constexpr int REC_OBUF_OFF = 2 * RB_FLOATS * 4;
constexpr int OB_LD = 68;
static_assert(REC_OBUF_OFF + 4 * TC * OB_LD * 4 <= MISC_OFF - 320, "recurrence LDS");
__device__ __forceinline__ float row16_allsum(float x) {
    x += __builtin_bit_cast(float, __builtin_amdgcn_update_dpp(0, __builtin_bit_cast(int, x), 0x128, 0xf, 0xf, false));
    x += __builtin_bit_cast(float, __builtin_amdgcn_update_dpp(0, __builtin_bit_cast(int, x), 0x124, 0xf, 0xf, false));
    x += __builtin_bit_cast(float, __builtin_amdgcn_update_dpp(0, __builtin_bit_cast(int, x), 0x122, 0xf, 0xf, false));
    x += __builtin_bit_cast(float, __builtin_amdgcn_update_dpp(0, __builtin_bit_cast(int, x), 0x121, 0xf, 0xf, false));
    return x;
}
struct RecItem { int n0, ntok, s, h, q; bool prompt; };
__device__ __forceinline__ RecItem rec_item(int b, int i) {
    RecItem it;
    if (i < 64) { it.prompt = true; it.s = b >> 5; it.h = (b >> 2) & 7; it.q = b & 3; it.n0 = it.s * 2048 + TC * i; it.ntok = TC; }
    else { const int su = b * 4 + (i - 64); it.prompt = false; it.s = su >> 3; it.h = su & 7; it.q = 0; it.n0 = MP + it.s * 4; it.ntok = 4; }
    return it;
}
struct RecPar { float mur, muk, muv, kkp, kap, rkp, w0p, a0p; };
struct RecRaw { unsigned short rr[9], kr[9], vr[9], ar[8], wr[8]; float fp[3]; RecPar P; };
__device__ __forceinline__ void rec_emit(const RecPar& P, float r, float k, float v, float araw, float wraw, LAS float* buf, int tt, int lane, float* bonus_out) {
    const float a = araw, w = 1.0f - wraw;
    const float kkr = k * P.kkp; const float ss2 = wave_sum(kkr * kkr); const float kk = kkr * fminf(__builtin_amdgcn_rsqf(ss2), 1e12f);
    const float k2 = k * (1.0f + (a - 1.0f) * P.kap), nb = -kk * a;
    const float bon = wave_sum(r * k2 * P.rkp);
    if (bonus_out && lane == 0) *bonus_out = bon;
    LAS float* bt = buf + tt * RB_TOK;
    bt[lane] = r; bt[64 + lane] = w; bt[128 + lane] = k2; bt[192 + lane] = kk; bt[256 + lane] = nb; buf[RB_VT + lane * VT_LD + tt] = v;
}
__device__ __forceinline__ void rec_load_raw(const Args& A, const RecItem& it, int pw, int lane, RecRaw& R) {
    const bf16* proj = (const bf16*)(A.ws + WS_PROJ); const bf16* lora = (const bf16*)A.out;
    const int c = it.h * 64 + lane;
    R.P.mur = A.in[I_MU][c]; R.P.muk = A.in[I_MU][512 + c]; R.P.muv = A.in[I_MU][1024 + c]; R.P.kkp = A.in[I_KK][c]; R.P.kap = A.in[I_KA][c]; R.P.rkp = A.in[I_RK][c]; R.P.w0p = A.in[I_W0][c]; R.P.a0p = A.in[I_A0][c];
    if (it.prompt) {
        const int n1 = it.n0 + pw * 8; const bool has_prev = (n1 & 2047) != 0;
        const bf16* pr = proj + (size_t)n1 * PTOT + c; const bf16* lr = lora + (size_t)n1 * NLORA + c;
        R.rr[0] = 0; R.kr[0] = 0; R.vr[0] = 0;
        if (has_prev) { R.rr[0] = pr[-PTOT]; R.kr[0] = pr[512 - PTOT]; R.vr[0] = pr[1024 - PTOT]; }
#pragma unroll
        for (int i = 0; i < 8; ++i) { R.rr[i + 1] = pr[(size_t)i * PTOT]; R.kr[i + 1] = pr[(size_t)i * PTOT + 512]; R.vr[i + 1] = pr[(size_t)i * PTOT + 1024]; R.wr[i] = lr[(size_t)i * NLORA]; R.ar[i] = lr[(size_t)i * NLORA + 512]; }
    } else {
        const int tt = pw, n = it.n0 + tt; const bf16* pr = proj + (size_t)n * PTOT + c;
        R.rr[1] = pr[0]; R.kr[1] = pr[512]; R.vr[1] = pr[1024]; R.ar[0] = lora[(size_t)n * NLORA + 512 + c]; R.wr[0] = lora[(size_t)n * NLORA + c];
        if (tt > 0) { R.fp[0] = bf2f(pr[-PTOT]); R.fp[1] = bf2f(pr[512 - PTOT]); R.fp[2] = bf2f(pr[1024 - PTOT]); }
        else { const float* ss = A.in[I_SSH] + (size_t)it.s * PSH + c; R.fp[0] = ss[0]; R.fp[1] = ss[512]; R.fp[2] = ss[1024]; }
    }
}
__device__ __forceinline__ void rec_compute(const Args& A, const RecItem& it, bool has_nx, const RecItem& nx, int pw, int lane, RecRaw& R, LAS float* buf) {
    float* bonus = (float*)(A.ws + WS_BONUS); const RecPar P = R.P;
    if (it.prompt) {
        const int n1 = it.n0 + pw * 8; const bool inter = has_nx && nx.prompt;
        const int m1 = nx.n0 + pw * 8; const bool nx_prev = (m1 & 2047) != 0;
        const bf16* pr = (const bf16*)(A.ws + WS_PROJ) + (size_t)m1 * PTOT + it.h * 64 + lane; const bf16* lr = (const bf16*)A.out + (size_t)m1 * NLORA + it.h * 64 + lane;
        LAS float* b0 = buf + (pw * 8) * RB_TOK;
        float vr_[8], vw_[8], vk2[8], vkkr[8], va[8], vv[8];
#pragma unroll
        for (int i = 0; i < 8; ++i) {
            const float rc = bf2f(R.rr[i + 1]), kc = bf2f(R.kr[i + 1]), vc = bf2f(R.vr[i + 1]), rp = bf2f(R.rr[i]), kp = bf2f(R.kr[i]), vp = bf2f(R.vr[i]);
            const float ai = bf2f(R.ar[i]), wi = bf2f(R.wr[i]);
            if (inter) {
                if (i > 0 || nx_prev) { R.rr[i] = pr[(ptrdiff_t)(i - 1) * PTOT]; R.kr[i] = pr[(ptrdiff_t)(i - 1) * PTOT + 512]; R.vr[i] = pr[(ptrdiff_t)(i - 1) * PTOT + 1024]; } else { R.rr[0] = 0; R.kr[0] = 0; R.vr[0] = 0; }
                R.wr[i] = lr[(size_t)i * NLORA]; R.ar[i] = lr[(size_t)i * NLORA + 512];
                if (i == 7) { R.rr[8] = pr[(size_t)7 * PTOT]; R.kr[8] = pr[(size_t)7 * PTOT + 512]; R.vr[8] = pr[(size_t)7 * PTOT + 1024]; } }
            const float r = rc + P.mur * (rp - rc), k = kc + P.muk * (kp - kc); vv[i] = vc + P.muv * (vp - vc);
            const float a = ai; vw_[i] = 1.0f - wi;
            const float kkr = k * P.kkp, k2 = k * (1.0f + (a - 1.0f) * P.kap);
            vr_[i] = r; vk2[i] = k2; vkkr[i] = kkr; va[i] = a;
            b0[i * RB_TOK + lane] = kkr * kkr; b0[i * RB_TOK + 64 + lane] = r * k2 * P.rkp;
        }
        { const int sidx = lane >> 2, tok = sidx & 7, which = sidx >> 3, part = lane & 3;
          const LAS f32x4* p = (const LAS f32x4*)(b0 + tok * RB_TOK + which * 64 + part * 16);
          const f32x4 s4 = (p[0] + p[1]) + (p[2] + p[3]); float s = (s4.x + s4.y) + (s4.z + s4.w);
          s += __builtin_bit_cast(float, __builtin_amdgcn_update_dpp(0, __builtin_bit_cast(int, s), 0xB1, 0xf, 0xf, false));
          s += __builtin_bit_cast(float, __builtin_amdgcn_update_dpp(0, __builtin_bit_cast(int, s), 0x4E, 0xf, 0xf, false));
          const float rn = fminf(__builtin_amdgcn_rsqf(s), 1e12f);
          if (part == 0) { if (which == 0) b0[128 + tok] = rn; else if (it.q == 0) bonus[(size_t)(n1 + tok) * 8 + it.h] = s; } }
        const f32x4 rn0 = *(const LAS f32x4*)(b0 + 128), rn1 = *(const LAS f32x4*)(b0 + 132);
#pragma unroll
        for (int i = 0; i < 8; ++i) { const float rn = i < 4 ? rn0[i & 3] : rn1[i & 3]; const float kk = vkkr[i] * rn; LAS float* bt = b0 + i * RB_TOK;
            bt[lane] = vr_[i]; bt[64 + lane] = vw_[i]; bt[128 + lane] = vk2[i]; bt[192 + lane] = kk; bt[256 + lane] = -kk * va[i]; buf[RB_VT + lane * VT_LD + pw * 8 + i] = vv[i]; }
        if (has_nx && !inter) rec_load_raw(A, nx, pw, lane, R);
    } else {
        const int tt = pw, n = it.n0 + tt; const float rc = bf2f(R.rr[1]), kc = bf2f(R.kr[1]), vc = bf2f(R.vr[1]);
        const float f0 = R.fp[0], f1 = R.fp[1], f2 = R.fp[2], ai = bf2f(R.ar[0]), wi = bf2f(R.wr[0]);
        if (has_nx) rec_load_raw(A, nx, pw, lane, R);
        rec_emit(P, rc + P.mur * (f0 - rc), kc + P.muk * (f1 - kc), vc + P.muv * (f2 - vc), ai, wi, buf, tt, lane, bonus + (size_t)n * 8 + it.h);
    }
}
typedef float f32x2 __attribute__((ext_vector_type(2)));
struct RV { f32x4 kk, w, nb, k, r; };
__device__ __forceinline__ void rec_load(RV& X, const LAS float* bt, int l) {
    X.kk = *(const LAS f32x4*)(bt + 192 + 4 * l); X.w = *(const LAS f32x4*)(bt + 64 + 4 * l); X.nb = *(const LAS f32x4*)(bt + 256 + 4 * l);
    X.k = *(const LAS f32x4*)(bt + 128 + 4 * l); X.r = *(const LAS f32x4*)(bt + 4 * l);
}
__device__ __forceinline__ float rec_comp(f32x4& S, const RV& X, float vi) {
    f32x2 p = S.xy * X.kk.xy; p = S.zw * X.kk.zw + p; float d_ = row16_allsum(p.x + p.y);
    const f32x4 T_ = S * X.w + X.k * vi; S = T_ + X.nb * d_;
    f32x2 q = S.xy * X.r.xy; q = S.zw * X.r.zw + q; return q.x + q.y;
}
#define REC_BAR() do { asm volatile("s_waitcnt lgkmcnt(0)" ::: "memory"); __builtin_amdgcn_s_barrier(); asm volatile("" ::: "memory"); } while (0)
__device__ __forceinline__ void phase_recurrence(const Args& A, Frame& F) {
    LAS float* bufs = (LAS float*)F.lds;
    LAS float* obuf = (LAS float*)(F.lds + REC_OBUF_OFF) + (F.wave & 3) * (TC * OB_LD);
    bf16* mix = (bf16*)(A.ws + WS_MIX);
    const int b = blockIdx.x, lane = F.lane, w = F.wave, l = lane & 15, rg = lane >> 4;
    constexpr int NIT = 68;
    f32x4 S = (f32x4){0.f, 0.f, 0.f, 0.f};
    RecRaw R;
    if (w >= 4) { rec_load_raw(A, rec_item(b, 0), w - 4, lane, R); rec_compute(A, rec_item(b, 0), true, rec_item(b, 1), w - 4, lane, R, bufs); }
    REC_BAR();
    for (int i = 0; i < NIT; ++i) {
        if (w >= 4) {
            if (i + 1 < NIT) rec_compute(A, rec_item(b, i + 1), i + 2 < NIT, rec_item(b, i + 2 < NIT ? i + 2 : i + 1), w - 4, lane, R, bufs + ((i + 1) & 1) * RB_FLOATS);
        } else {
            __builtin_amdgcn_s_setprio(2);
            const RecItem it = rec_item(b, i); const LAS float* buf = bufs + (i & 1) * RB_FLOATS;
            if (it.prompt) {
                const int irow = it.q * 16 + w * 4 + rg; const LAS float* vrow = buf + RB_VT + irow * VT_LD; float opv[TC];
f32x4 v4[TC / 4];
#pragma unroll
                for (int t4 = 0; t4 < TC / 4; ++t4) v4[t4] = *(const LAS f32x4*)(vrow + 4 * t4);
                RV X[4]; rec_load(X[0], buf, l); rec_load(X[1], buf + RB_TOK, l); rec_load(X[2], buf + 2 * RB_TOK, l);
#pragma unroll
                for (int t = 0; t < TC; ++t) {
                    if (t + 3 < TC) rec_load(X[(t + 3) & 3], buf + (t + 3) * RB_TOK, l);
                    __builtin_amdgcn_sched_barrier(0);
                    opv[t] = rec_comp(S, X[t & 3], v4[t >> 2][t & 3]);
                    __builtin_amdgcn_sched_barrier(0);
                }
#pragma unroll
                for (int t = 0; t < TC; ++t) obuf[t * OB_LD + lane] = opv[t];
                { const int t = lane >> 1, pr2 = lane & 1; const LAS f32x4* p0 = (const LAS f32x4*)(obuf + t * OB_LD + pr2 * 32);
                  const f32x4 a0 = p0[0], a1 = p0[1], a2 = p0[2], a3 = p0[3], b0 = p0[4], b1 = p0[5], b2 = p0[6], b3 = p0[7];
                  const f32x4 sa = (a0 + a1) + (a2 + a3), sb = (b0 + b1) + (b2 + b3);
                  const float o0 = (sa.x + sa.y) + (sa.z + sa.w), o1 = (sb.x + sb.y) + (sb.z + sb.w);
                  *(GAS unsigned*)(mix + (size_t)(it.n0 + t) * D + it.h * 64 + it.q * 16 + w * 4 + 2 * pr2) = pkbf(o0, o1); }
                if (i == 63) *(GAS f32x4*)(A.out + O_WKVP + ((size_t)(it.s * 8 + it.h) * 64 + irow) * 64 + 4 * l) = S;
            } else {
                f32x4 Sq[4]; float ops[16];
#pragma unroll
                for (int qq = 0; qq < 4; ++qq) Sq[qq] = *(const GAS f32x4*)(A.in[I_SWKV] + ((size_t)(it.s * 8 + it.h) * 64 + qq * 16 + w * 4 + rg) * 64 + 4 * l);
#pragma unroll
                for (int qq = 0; qq < 4; ++qq) { const int irow = qq * 16 + w * 4 + rg; const f32x4 v4 = *(const LAS f32x4*)(buf + RB_VT + irow * VT_LD);
#pragma unroll
                    for (int t = 0; t < 4; ++t) { RV X; rec_load(X, buf + t * RB_TOK, l); ops[t * 4 + qq] = rec_comp(Sq[qq], X, v4[t]); }
                    *(GAS f32x4*)(A.out + O_WKVS + ((size_t)(it.s * 8 + it.h) * 64 + irow) * 64 + 4 * l) = Sq[qq]; }
#pragma unroll
                for (int x = 0; x < 16; ++x) obuf[x * OB_LD + lane] = ops[x];
                { const int t = lane >> 4, qq = (lane >> 2) & 3, rr = lane & 3; const LAS f32x4* p0 = (const LAS f32x4*)(obuf + (t * 4 + qq) * OB_LD + rr * 16);
                  const f32x4 sa = (p0[0] + p0[1]) + (p0[2] + p0[3]); const float o = (sa.x + sa.y) + (sa.z + sa.w);
                  mix[(size_t)(it.n0 + t) * D + it.h * 64 + qq * 16 + w * 4 + rr] = (bf16)(pkbf(o, 0.f) & 0xffffu); }
            }
            __builtin_amdgcn_s_setprio(0);
        }
        REC_BAR();
    }
}

__device__ __forceinline__ void phase_post(const Args& A, Frame& F) {
    unsigned char* ws = A.ws; const bf16* proj = (const bf16*)(ws + WS_PROJ); bf16* mix = (bf16*)(ws + WS_MIX);
    const bf16* recg = (const bf16*)A.out + 1024;   const float* bonus = (const float*)(ws + WS_BONUS);
    const int lane = F.lane, c0 = 8 * lane, h = lane >> 3;
    float muv[8], lg[8], lb[8];
#pragma unroll
    for (int e = 0; e < 8; ++e) { muv[e] = A.in[I_MU][OFF_V + c0 + e]; lg[e] = A.in[I_LNXG][c0 + e]; lb[e] = A.in[I_LNXB][c0 + e]; }
    for (int n = F.gw; n < M; n += F.NGW) {
        const Tok k = tok_of(n);
        const v4u ow = *(const GAS v4u*)(mix + (size_t)n * D + c0), gw4 = *(const GAS v4u*)(recg + (size_t)n * NLORA + c0), vcw = *(const GAS v4u*)(proj + (size_t)n * PTOT + OFF_V + c0);
        float o[8], g[8], v[8], vp[8];
#pragma unroll
        for (int e = 0; e < 4; ++e) { o[2 * e] = bflo(ow[e]); o[2 * e + 1] = bfhi(ow[e]); g[2 * e] = bflo(gw4[e]); g[2 * e + 1] = bfhi(gw4[e]); v[2 * e] = bflo(vcw[e]); v[2 * e + 1] = bfhi(vcw[e]); }
        if (k.t > 0) { const v4u pw4 = *(const GAS v4u*)(proj + (size_t)(n - 1) * PTOT + OFF_V + c0);
#pragma unroll
            for (int e = 0; e < 4; ++e) { vp[2 * e] = bflo(pw4[e]); vp[2 * e + 1] = bfhi(pw4[e]); } }
        else {
#pragma unroll
            for (int e = 0; e < 8; ++e) vp[e] = k.prompt ? 0.f : A.in[I_SSH][(size_t)k.s * PSH + OFF_V + c0 + e]; }
        float s = 0.f;
#pragma unroll
        for (int e = 0; e < 8; ++e) s += o[e];
        s += __shfl_xor(s, 1); s += __shfl_xor(s, 2); s += __shfl_xor(s, 4);
        const float mean = s * (1.f / 64.f); float q = 0.f;
#pragma unroll
        for (int e = 0; e < 8; ++e) { o[e] -= mean; q += o[e] * o[e]; }
        q += __shfl_xor(q, 1); q += __shfl_xor(q, 2); q += __shfl_xor(q, 4);
        const float rstd = 1.0f / sqrtf(q * (1.f / 64.f) + GN_EPS); const float bon = bonus[(size_t)n * 8 + h];
        float y[8];
#pragma unroll
        for (int e = 0; e < 8; ++e) { const float vm = v[e] + muv[e] * (vp[e] - v[e]); y[e] = (o[e] * rstd * lg[e] + lb[e] + bon * vm) * g[e]; }
        v4u ov; ov.x = pkbf(y[0], y[1]); ov.y = pkbf(y[2], y[3]); ov.z = pkbf(y[4], y[5]); ov.w = pkbf(y[6], y[7]);
        *(GAS v4u*)(mix + (size_t)n * D + c0) = ov;
    }
}

__global__ void __launch_bounds__(NWAVES * 64, 2) mk_fwd(Args A) {
    extern __shared__ __attribute__((aligned(16))) unsigned char lds_raw[];
    Frame F; F.lds = (LAS unsigned char*)lds_raw; F.tid = threadIdx.x; F.lane = F.tid & 63; F.wave = __builtin_amdgcn_readfirstlane(F.tid >> 6);
    F.G = gridDim.x; F.gw = blockIdx.x * NWAVES + F.wave; F.NGW = F.G * NWAVES;
    volatile LAS unsigned* MISC = (volatile LAS unsigned*)(F.lds + MISC_OFF);
    for (int u = F.tid; u < (LDS_BYTES - MISC_OFF) / 4; u += NWAVES * 64) ((LAS unsigned*)(F.lds + MISC_OFF))[u] = 0u;
    __syncthreads();
    unsigned char* ws = A.ws;
    XcdBarrier bar = xcd_barrier_post((unsigned*)(ws + WS_CTL) + CW_BAR, MISC + 8);
#define GRID_BAR() xcd_barrier(bar)
    bf16* XB = (bf16*)(ws + WS_XB); bf16* HB = (bf16*)(ws + WS_H); bf16* PROJ = (bf16*)(ws + WS_PROJ); bf16* AP = (bf16*)(ws + WS_AP); bf16* MIX = (bf16*)(ws + WS_MIX);
    float* Z = A.out + O_Y;
    LAS unsigned char* ring = F.lds;

#ifndef PHMASK
#define PHMASK 0xFFFF
#endif
#if (PHMASK >> 0) & 1
    phase_prologue(A, F); GRID_BAR();
#endif
#if (PHMASK >> 1) & 1
    { pg8::Gemm g{XB, (const bf16*)(ws + WS_WGU1), M, NGU, D}; pg8::StaticOrder S; S.init(M, NGU, F.G, (int)blockIdx.x); pg8::EpiSwiGLU E{HB, FF};
      pg8::gemm_phase<pg8::EpiSwiGLU, pg8::StaticOrder, true, true>(ring, g, S, E); }
#endif
    GRID_BAR();
#if (PHMASK >> 2) & 1
    { pg8::Gemm g{HB, (const bf16*)(ws + WS_WD1), M, D, FF}; pg8::StaticOrder S; S.init(M, D, F.G, (int)blockIdx.x); pg8::EpiRes<false> E{A.in[I_XP], A.in[I_XS], MP / 256, Z, D, ALPHA, 0.5f};
      pg8::gemm_phase<pg8::EpiRes<false>, pg8::StaticOrder, true, true>(ring, g, S, E); }
#endif
    GRID_BAR();
#if (PHMASK >> 3) & 1
    phase_ln<false>(F, Z, XB, A.in[I_LN1G], A.in[I_LN1B]); GRID_BAR();
#endif
#if (PHMASK >> 4) & 1
    { pg8::Gemm g{XB, (const bf16*)(ws + WS_WIN), M, PTOT, D}; pg8::StaticOrder S; S.init(M, PTOT, F.G, (int)blockIdx.x); pg8::EpiBf16<0> E{PROJ, PTOT, nullptr, 0, 0, 1.f};
      pg8::gemm_phase<pg8::EpiBf16<0>, pg8::StaticOrder, true, true>(ring, g, S, E); }
#endif
    GRID_BAR();
#if (PHMASK >> 5) & 1
    phase_prep(A, F); GRID_BAR();
#endif
#if (PHMASK >> 6) & 1
    { int klora = KLORA; asm volatile("" : "+s"(klora));
      pg8::Gemm g{AP, (const bf16*)(ws + WS_WL), M, NLORA, klora}; pg8::StaticOrder S; S.init(M, NLORA, F.G, (int)blockIdx.x);
      pg8::EpiLoraAct E{(bf16*)A.out, (const float*)(ws + WS_LBIAS)};
      pg8::gemm_phase<pg8::EpiLoraAct, pg8::StaticOrder, true, true>(ring, g, S, E); }
#endif
    GRID_BAR();
#if (PHMASK >> 7) & 1
    phase_recurrence(A, F); GRID_BAR();
#endif
#if (PHMASK >> 8) & 1
    phase_post(A, F); GRID_BAR();
#endif
#if (PHMASK >> 9) & 1
    { pg8::Gemm g{MIX, (const bf16*)(ws + WS_WOUT), M, D, D}; pg8::StaticOrder S; S.init(M, D, F.G, (int)blockIdx.x); pg8::EpiRes<true> E{XB, XB, 1 << 30, Z, D, ALPHA, 1.0f};
      pg8::gemm_phase<pg8::EpiRes<true>, pg8::StaticOrder, true, true>(ring, g, S, E); }
#endif
    GRID_BAR();
#if (PHMASK >> 10) & 1
    phase_ln<false>(F, Z, XB, A.in[I_LN2G], A.in[I_LN2B]); GRID_BAR();
#endif
#if (PHMASK >> 11) & 1
    { pg8::Gemm g{XB, (const bf16*)(ws + WS_WGU2), M, NGU, D}; pg8::StaticOrder S; S.init(M, NGU, F.G, (int)blockIdx.x); pg8::EpiSwiGLU E{HB, FF};
      pg8::gemm_phase<pg8::EpiSwiGLU, pg8::StaticOrder, true, true>(ring, g, S, E); }
#endif
    GRID_BAR();
#if (PHMASK >> 12) & 1
    { pg8::Gemm g{HB, (const bf16*)(ws + WS_WD2), M, D, FF}; pg8::StaticOrder S; S.init(M, D, F.G, (int)blockIdx.x); pg8::EpiRes<true> E{XB, XB, 1 << 30, Z, D, ALPHA, 0.5f};
      pg8::gemm_phase<pg8::EpiRes<true>, pg8::StaticOrder, true, true>(ring, g, S, E); }
#endif
    GRID_BAR();
#if (PHMASK >> 13) & 1
    phase_ln<true>(F, Z, XB, A.in[I_LN3G], A.in[I_LN3B]);
#endif
}

extern "C" void kernel_launch(void* const* d_in, const int* in_sizes, int n_in, void* d_out, int out_size, void* d_ws, size_t ws_size, hipStream_t stream) {
    static int grid = 0;
    if (grid == 0) {
        if (n_in != 31 || out_size != (int)O_END || ws_size < WS_END) { fprintf(stderr, "kernel_launch: unexpected sizes n_in %d out %d ws %zu\n", n_in, out_size, ws_size); grid = -1; return; }
        int dev = 0, cus = 0, per_cu = 0;
        if (hipGetDevice(&dev) != hipSuccess || hipDeviceGetAttribute(&cus, hipDeviceAttributeMultiprocessorCount, dev) != hipSuccess) { grid = -1; return; }
        if (hipFuncSetAttribute((const void*)mk_fwd, hipFuncAttributeMaxDynamicSharedMemorySize, LDS_BYTES) != hipSuccess) { fprintf(stderr, "kernel_launch: hipFuncSetAttribute failed\n"); grid = -1; return; }
        if (hipOccupancyMaxActiveBlocksPerMultiprocessor(&per_cu, (const void*)mk_fwd, NWAVES * 64, LDS_BYTES) != hipSuccess || per_cu < 1) { fprintf(stderr, "kernel_launch: occupancy query says %d\n", per_cu); (void)hipGetLastError(); grid = -1; return; }
        if (cus != 256) { fprintf(stderr, "kernel_launch: built for 256 CUs, found %d\n", cus); grid = -1; return; }
        grid = 256;
    }
    if (grid < 0) return;
    (void)hipMemsetAsync((char*)d_ws + WS_CTL, 0, CTL_ZERO_BYTES, stream);
    Args a{};
    for (int i = 0; i < 31; ++i) a.in[i] = (const float*)d_in[i];
    a.out = (float*)d_out; a.ws = (unsigned char*)d_ws;
    hipLaunchKernelGGL(mk_fwd, dim3(grid), dim3(NWAVES * 64), LDS_BYTES, stream, a);
}
```

```cpp
#include <hip/hip_runtime.h>
#include <cstdio>
#include <cstdint>
namespace pg8 {
#define PG8_LAS __attribute__((address_space(3)))
typedef unsigned short bf16_t;
typedef short bf16x8 __attribute__((ext_vector_type(8)));
typedef float f32x4 __attribute__((ext_vector_type(4)));
typedef unsigned u32x4 __attribute__((ext_vector_type(4)));
constexpr int BM = 256, BK = 64, HALF = 128, HTB = HALF * BK * 2  , STAGE_BYTES = 8 * HTB, NXCD = 8, WGM = 8;

__host__ __device__ __forceinline__ int lds_byte(int r, int c) { const int st = (r >> 4) * 2 + (c >> 5), rr = r & 15, cc = c & 31, ob = rr * 64 + cc * 2; return st * 1024 + (ob ^ (((ob >> 9) & 1) << 5)); }
__host__ __device__ __forceinline__ void stage_rc(int b, int& R, int& C) { const int st = b / 1024, sb = b % 1024, swz = sb ^ (((sb >> 9) & 1) << 5); R = (st >> 1) * 16 + swz / 64; C = (st & 1) * 32 + (swz % 64) / 2; }
__host__ __device__ __forceinline__ int perm32(int rho) { const int n = rho >> 4, i = rho & 15; return 8 * (i >> 2) + 4 * n + (i & 3); }

struct Unit { int pm, pn, k0, nt; };
struct Gemm { const bf16_t* A; const bf16_t* Bt; int M, N, K; };

struct StaticOrder {
    int nM, nN, nwg, G, c, ntk;
    __host__ __device__ void init(int M, int N, int G_, int c_, int K) { nM = M / BM; nN = N / BM; nwg = nM * nN; G = G_; c = c_; ntk = K / BK; }
    __host__ __device__ bool next(int i, Unit& u) const {
        const long L = (long)i * G + c; if (L >= nwg) return false;
        int wgid = (int)L; { const int q = nwg / NXCD, r = nwg % NXCD, xcd = wgid % NXCD, off = wgid / NXCD; wgid = (xcd < r ? xcd * (q + 1) : r * (q + 1) + (xcd - r) * q) + off; }
        const int nig = WGM * nN, gid = wgid / nig, fm = gid * WGM, gsz = (nM - fm) < WGM ? (nM - fm) : WGM;
        u.pm = fm + ((wgid % nig) % gsz); u.pn = (wgid % nig) / gsz; u.k0 = 0; u.nt = ntk; return true;
    }
    __device__ __forceinline__ void a_ready(const Unit&) const {}
    __device__ __forceinline__ void done(const Unit&) const {}
};

struct SplitOrder {
    StaticOrder base; int nsp, per, kc, c;
    __host__ __device__ void init(int Mp, int N, int G_, int c_, int K, int kc_) { base.init(Mp, N, G_, c_, K); kc = kc_; per = (K / BK) / kc_; nsp = 2 * (N / BM) * per; c = c_; }
    __host__ __device__ bool next(int i, Unit& u) const {
        if (i == 0) return base.next(0, u);
        if (i == 1 && c < nsp) { const int tile = c / per, ks = c % per; u.pm = base.nM + tile / base.nN; u.pn = tile % base.nN; u.k0 = ks * kc; u.nt = kc; return true; }
        return false;
    }
    __device__ __forceinline__ void a_ready(const Unit&) const {}
    __device__ __forceinline__ void done(const Unit&) const {}
};
__device__ __forceinline__ unsigned cvt_pk_bf16(float lo, float hi) { unsigned r; asm volatile("v_cvt_pk_bf16_f32 %0, %1, %2" : "=v"(r) : "v"(lo), "v"(hi)); return r; }
typedef float f32x2 __attribute__((ext_vector_type(2)));
__device__ __forceinline__ f32x2 gelu_pk(f32x2 v) {
    const f32x2 av = __builtin_elementwise_abs(v), d = av * 0.2316418882f + 1.0f;
    f32x2 t; t.x = __builtin_amdgcn_rcpf(d.x); t.y = __builtin_amdgcn_rcpf(d.y);
    f32x2 q = t * 0.5307027145f + (-0.7265760135f); q = q * t + 0.7107068705f; q = q * t + (-0.142248368f); q = q * t + 0.127414796f; q = q * t;
    const f32x2 s = (v * v) * (-0.72134752044f);
    f32x2 e; e.x = __builtin_amdgcn_exp2f(s.x); e.y = __builtin_amdgcn_exp2f(s.y);
    const f32x2 m = v * (q * e), r = v - m;
    f32x2 o; o.x = v.x < 0.f ? m.x : r.x; o.y = v.y < 0.f ? m.y : r.y; return o;
}

__device__ __forceinline__ f32x4 lora_act(f32x4 v, int ty) {
    f32x4 s; s.x = __builtin_amdgcn_rcpf(1.0f + __expf(-v.x)); s.y = __builtin_amdgcn_rcpf(1.0f + __expf(-v.y)); s.z = __builtin_amdgcn_rcpf(1.0f + __expf(-v.z)); s.w = __builtin_amdgcn_rcpf(1.0f + __expf(-v.w));
    if (ty == 0) { s.x = 1.0f - __expf(-0.6065306597126334f * s.x); s.y = 1.0f - __expf(-0.6065306597126334f * s.y); s.z = 1.0f - __expf(-0.6065306597126334f * s.z); s.w = 1.0f - __expf(-0.6065306597126334f * s.w); }
    return s;
}
template <int ACT  > struct EpiBf16 {
    static constexpr bool PERM = true, AFTER_DRAIN = false; static_assert(ACT >= 0 && ACT <= 2, "EpiBf16: ACT is 0 (none), 1 (gelu_pk) or 2 (LoRA: tiles 0,1 -> 1 - decay, 2,3 -> sigmoid, 4,5 -> identity)");
    bf16_t* O; int ldc; const float* bias; int split_cols; size_t split_stride; float scale0;
    __device__ __forceinline__ void operator()(const f32x4 (&acc)[2][2][4][2], const Unit& u, int wr, int wc, int fr, int fq) const {
        const int row0 = u.pm * BM + wr * 64 + fr; int colt = u.pn * BM; bf16_t* base = O;
        float sc = 1.f; if (split_cols) { const int t = colt / split_cols; base += (size_t)t * split_stride; colt -= t * split_cols; if (t == 0) sc = scale0; }
        const int col0 = colt + wc * 32 + 8 * fq, bcol0 = u.pn * BM + wc * 32 + 8 * fq;
        f32x4 bv[2][2];
#pragma unroll
        for (int bj = 0; bj < 2; ++bj)
#pragma unroll
            for (int n = 0; n < 2; ++n) bv[bj][n] = bias ? *(const f32x4*)(bias + bcol0 + bj * HALF + 4 * n) : (f32x4){0.f, 0.f, 0.f, 0.f};
#pragma unroll
        for (int ai = 0; ai < 2; ++ai)
#pragma unroll
            for (int m = 0; m < 4; ++m) { bf16_t* rowp = base + (size_t)(row0 + ai * HALF + m * 16) * ldc + col0;
#pragma unroll
                for (int bj = 0; bj < 2; ++bj) { f32x4 v0 = acc[ai][bj][m][0] + bv[bj][0], v1 = acc[ai][bj][m][1] + bv[bj][1];
                    if (ACT == 2) { const int ty = u.pn >> 1;
                        if (ty < 2) { v0 = lora_act(v0, ty); asm volatile("" : "+v"(v0)); v1 = lora_act(v1, ty); asm volatile("" : "+v"(v1)); } }
                    if (ACT == 1) { f32x2 a = gelu_pk((f32x2){v0[0], v0[1]}), b = gelu_pk((f32x2){v0[2], v0[3]}), c = gelu_pk((f32x2){v1[0], v1[1]}), d = gelu_pk((f32x2){v1[2], v1[3]});
                        v0 = (f32x4){a.x, a.y, b.x, b.y}; v1 = (f32x4){c.x, c.y, d.x, d.y}; }
                    v0 = v0 * sc; v1 = v1 * sc; u32x4 w; w.x = cvt_pk_bf16(v0[0], v0[1]); w.y = cvt_pk_bf16(v0[2], v0[3]); w.z = cvt_pk_bf16(v1[0], v1[1]); w.w = cvt_pk_bf16(v1[2], v1[3]);
                    *(u32x4*)(rowp + bj * HALF) = w; } }
    }
};
template <class Epi, class Sched, bool ALIGN_EPI = false, bool SP2 = false>
__device__ __forceinline__ void gemm_phase(PG8_LAS unsigned char* lds, const Gemm g, const Sched& S, const Epi& E) {
    const int tid = threadIdx.x, wid = __builtin_amdgcn_readfirstlane(tid >> 6), lane = tid & 63, wr = wid >> 2, wc = wid & 3, fr = lane & 15, fq = lane >> 4;
    const int K = g.K;
    unsigned voffA[2], voffB[2];
#pragma unroll
    for (int i = 0; i < 2; ++i) { int R, C; stage_rc(tid * 16 + i * 8192, R, C); const int Rb = Epi::PERM ? ((R & ~31) + perm32(R & 31)) : R;
        voffA[i] = (unsigned)(R * K + C) * 2u; voffB[i] = (unsigned)(Rb * K + C) * 2u; }
    const size_t kstep = (size_t)(BK * 2);
    const size_t hstep = (size_t)HALF * K * 2;
    const size_t tstep = 2 * hstep;
    const unsigned ldsw = (unsigned)wid * 1024u;
    const int aoff = lds_byte(wr * 64 + fr, fq * 8), boff = lds_byte(wc * 32 + fr, fq * 8);
#define PG8_SA(b, h) (((b) * 2 + (h)) * HTB)
#define PG8_SB(b, h) ((4 + (b) * 2 + (h)) * HTB)
#define PG8_STAGE(bufoff, gbase, voff) do { _Pragma("unroll") for (int _i = 0; _i < 2; ++_i) \
        __builtin_amdgcn_global_load_lds((const unsigned*)((const char*)(gbase) + (voff)[_i]), (PG8_LAS unsigned*)(lds + (bufoff) + ldsw + _i * 8192), 16, 0, 0); } while (0)
#define PG8_LDA(dst, b, h) do { _Pragma("unroll") for (int m = 0; m < 4; ++m) _Pragma("unroll") for (int k = 0; k < 2; ++k) dst[m][k] = *(const PG8_LAS bf16x8*)(lds + PG8_SA(b, h) + aoff + m * 2048 + k * 1024); } while (0)
#define PG8_LDB(dst, b, h) do { _Pragma("unroll") for (int n = 0; n < 2; ++n) _Pragma("unroll") for (int k = 0; k < 2; ++k) dst[n][k] = *(const PG8_LAS bf16x8*)(lds + PG8_SB(b, h) + boff + n * 2048 + k * 1024); } while (0)
#define PG8_MMA(ai, bj, At, Bt) do { __builtin_amdgcn_s_setprio(1); _Pragma("unroll") for (int m = 0; m < 4; ++m) _Pragma("unroll") for (int n = 0; n < 2; ++n) _Pragma("unroll") for (int k = 0; k < 2; ++k) \
        acc[ai][bj][m][n] = __builtin_amdgcn_mfma_f32_16x16x32_bf16(Bt[n][k], At[m][k], acc[ai][bj][m][n], 0, 0, 0); __builtin_amdgcn_s_setprio(0); } while (0)
#define PG8_WAIT_V(n) asm volatile("s_waitcnt vmcnt(" #n ")" ::: "memory")
#define PG8_WAIT_L(n) asm volatile("s_waitcnt lgkmcnt(" #n ")" ::: "memory")
#define PG8_BAR __builtin_amdgcn_s_barrier()
#define PG8_SCHED __builtin_amdgcn_sched_barrier(0)
    Unit cur, nxt; int ui = 0;
    if (!S.next(0, cur)) return;
    f32x4 acc[2][2][4][2];
#pragma unroll
    for (int a = 0; a < 2; ++a)
#pragma unroll
        for (int b = 0; b < 2; ++b)
#pragma unroll
            for (int m = 0; m < 4; ++m)
#pragma unroll
                for (int n = 0; n < 2; ++n) acc[a][b][m][n] = (f32x4){0.f, 0.f, 0.f, 0.f};
    bf16x8 At[4][2], B0[2][2], B1[2][2];
    const char* cA = (const char*)g.A + (size_t)cur.pm * tstep + (size_t)cur.k0 * kstep; const char* cB = (const char*)g.Bt + (size_t)cur.pn * tstep + (size_t)cur.k0 * kstep;
    S.a_ready(cur);
    if constexpr (SP2) {
        PG8_STAGE(PG8_SB(0, 0), cB, voffB); PG8_STAGE(PG8_SB(0, 1), cB + hstep, voffB); PG8_STAGE(PG8_SA(0, 0), cA, voffA); PG8_STAGE(PG8_SA(0, 1), cA + hstep, voffA);
        if (wr == 1) PG8_BAR;
        PG8_WAIT_V(2); PG8_BAR;
        PG8_STAGE(PG8_SB(1, 0), cB + kstep, voffB); PG8_STAGE(PG8_SA(1, 0), cA + kstep, voffA); PG8_STAGE(PG8_SB(1, 1), cB + hstep + kstep, voffB);
        PG8_WAIT_V(6); PG8_BAR;
    } else {
        PG8_STAGE(PG8_SB(0, 0), cB, voffB); PG8_STAGE(PG8_SA(0, 0), cA, voffA); PG8_STAGE(PG8_SB(0, 1), cB + hstep, voffB); PG8_STAGE(PG8_SA(0, 1), cA + hstep, voffA);
        if (wr == 1) PG8_BAR;
        PG8_WAIT_V(4); PG8_BAR;
        PG8_STAGE(PG8_SB(1, 0), cB + kstep, voffB); PG8_STAGE(PG8_SA(1, 0), cA + kstep, voffA); PG8_STAGE(PG8_SB(1, 1), cB + hstep + kstep, voffB);
        PG8_WAIT_V(6); PG8_BAR;
    }
    for (;;) {
        const bool has_next = S.next(ui + 1, nxt);
        const char* nA = has_next ? (const char*)g.A + (size_t)nxt.pm * tstep + (size_t)nxt.k0 * kstep : cA; const char* nB = has_next ? (const char*)g.Bt + (size_t)nxt.pn * tstep + (size_t)nxt.k0 * kstep : cB;
        const int nt = cur.nt;
        for (int t = 0; t < nt; t += 2) {
            const bool last = (t == nt - 2);
            const char* a1 = cA + (size_t)(t + 1) * kstep;
            const char* a2 = last ? nA : cA + (size_t)(t + 2) * kstep; const char* b2 = last ? nB : cB + (size_t)(t + 2) * kstep;
            const char* a3 = a2 + kstep; const char* b3 = b2 + kstep;
            if (last && has_next) S.a_ready(nxt);
            if constexpr (SP2) {
            PG8_LDB(B0, 0, 0); PG8_LDB(B1, 0, 1); PG8_SCHED; PG8_LDA(At, 0, 0); PG8_STAGE(PG8_SA(1, 1), a1 + hstep, voffA);
            PG8_WAIT_V(8); PG8_WAIT_L(0); PG8_BAR; PG8_MMA(0, 0, At, B0); PG8_MMA(0, 1, At, B1); PG8_BAR; PG8_SCHED;
            PG8_LDA(At, 0, 1); PG8_STAGE(PG8_SB(0, 0), b2, voffB); PG8_STAGE(PG8_SB(0, 1), b2 + hstep, voffB); PG8_STAGE(PG8_SA(0, 0), a2, voffA);
            PG8_WAIT_V(8); PG8_WAIT_L(0); PG8_BAR; PG8_MMA(1, 0, At, B0); PG8_MMA(1, 1, At, B1); PG8_BAR; PG8_SCHED;
            PG8_LDB(B0, 1, 0); PG8_LDB(B1, 1, 1); PG8_SCHED; PG8_LDA(At, 1, 0); PG8_STAGE(PG8_SA(0, 1), a2 + hstep, voffA);
            PG8_WAIT_V(8); PG8_WAIT_L(0); PG8_BAR; PG8_MMA(0, 0, At, B0); PG8_MMA(0, 1, At, B1); PG8_BAR; PG8_SCHED;
            PG8_LDA(At, 1, 1); PG8_STAGE(PG8_SB(1, 0), b3, voffB); PG8_STAGE(PG8_SB(1, 1), b3 + hstep, voffB); PG8_STAGE(PG8_SA(1, 0), a3, voffA);
            PG8_WAIT_V(8); PG8_WAIT_L(0); PG8_BAR; PG8_MMA(1, 0, At, B0); PG8_MMA(1, 1, At, B1); PG8_BAR; PG8_SCHED;
            } else {
            PG8_LDB(B0, 0, 0); PG8_SCHED; PG8_LDA(At, 0, 0); PG8_STAGE(PG8_SA(1, 1), a1 + hstep, voffA);
            PG8_WAIT_L(8); PG8_BAR; PG8_WAIT_L(0); PG8_MMA(0, 0, At, B0); PG8_BAR; PG8_SCHED;
            PG8_LDB(B1, 0, 1); PG8_STAGE(PG8_SB(0, 0), b2, voffB);
            PG8_BAR; PG8_WAIT_L(0); PG8_MMA(0, 1, At, B1); PG8_BAR;
            PG8_LDA(At, 0, 1); PG8_STAGE(PG8_SA(0, 0), a2, voffA);
            PG8_BAR; PG8_WAIT_L(0); PG8_MMA(1, 0, At, B0); PG8_BAR; PG8_SCHED;
            PG8_STAGE(PG8_SB(0, 1), b2 + hstep, voffB);
            PG8_WAIT_V(6); PG8_BAR; PG8_MMA(1, 1, At, B1); PG8_BAR;
            PG8_LDB(B0, 1, 0); PG8_SCHED; PG8_LDA(At, 1, 0); PG8_STAGE(PG8_SA(0, 1), a2 + hstep, voffA);
            PG8_WAIT_L(8); PG8_BAR; PG8_WAIT_L(0); PG8_MMA(0, 0, At, B0); PG8_BAR; PG8_SCHED;
            PG8_LDB(B1, 1, 1); PG8_STAGE(PG8_SB(1, 0), b3, voffB);
            PG8_BAR; PG8_WAIT_L(0); PG8_MMA(0, 1, At, B1); PG8_BAR;
            PG8_LDA(At, 1, 1); PG8_STAGE(PG8_SA(1, 0), a3, voffA);
            PG8_BAR; PG8_WAIT_L(0); PG8_MMA(1, 0, At, B0); PG8_BAR; PG8_SCHED;
            PG8_STAGE(PG8_SB(1, 1), b3 + hstep, voffB);
            PG8_WAIT_V(6); PG8_BAR; PG8_MMA(1, 1, At, B1); PG8_BAR;
            }
        }
        if constexpr (ALIGN_EPI) { if (wr == 0) PG8_BAR; }
        if constexpr (!Epi::AFTER_DRAIN) { E(acc, cur, wr, wc, fr, fq); S.done(cur); }
        if (!has_next) break;
#pragma unroll
        for (int a = 0; a < 2; ++a)
#pragma unroll
            for (int b = 0; b < 2; ++b)
#pragma unroll
                for (int m = 0; m < 4; ++m)
#pragma unroll
                    for (int n = 0; n < 2; ++n) acc[a][b][m][n] = (f32x4){0.f, 0.f, 0.f, 0.f};
        cur = nxt; cA = nA; cB = nB; ++ui;
        if constexpr (ALIGN_EPI) { if (wr == 1) PG8_BAR; }
    }
    PG8_WAIT_V(0);
    if constexpr (!ALIGN_EPI) { if (wr == 0) PG8_BAR; }
    PG8_BAR;
    if constexpr (Epi::AFTER_DRAIN) { E.fused(acc, cur, wr, wc, fr, fq, lds, wid, lane); S.done(cur); }
#undef PG8_SA
#undef PG8_SB
#undef PG8_STAGE
#undef PG8_LDA
#undef PG8_LDB
#undef PG8_MMA
#undef PG8_WAIT_V
#undef PG8_WAIT_L
#undef PG8_BAR
#undef PG8_SCHED
}
}
#define GAS __attribute__((address_space(1)))
#define LAS __attribute__((address_space(3)))
typedef unsigned short bf16;
typedef unsigned v4u __attribute__((ext_vector_type(4)));
typedef float f32x4 __attribute__((ext_vector_type(4)));
typedef short bf16x8 __attribute__((ext_vector_type(8)));
typedef GAS unsigned gu32;
typedef GAS unsigned long long gu64;
#define RLX_AGENT __ATOMIC_RELAXED, __HIP_MEMORY_SCOPE_AGENT
#define LDS_WAIT() asm volatile("s_waitcnt lgkmcnt(0)" ::: "memory")
#define VM_WAIT() asm volatile("s_waitcnt vmcnt(0)" ::: "memory")
__device__ __forceinline__ unsigned long long rt() { return __builtin_amdgcn_s_memrealtime(); }
__device__ __forceinline__ unsigned f2bf(float f) { unsigned u = __builtin_bit_cast(unsigned, f); return (u + 0x7fffu + ((u >> 16) & 1u)) >> 16; }
__device__ __forceinline__ unsigned pk2(float lo, float hi) { return f2bf(lo) | (f2bf(hi) << 16); }

#define XB_TMO      128
#define XB_XCNT(j)  (256  + 64 * (j))
#define XB_XSUB(j)  (1280 + 64 * (j))
#define XB_XGEN(j)  (2304 + 64 * (j))
#define XB_TOP      3328
#define XB_TOPGEN   3392
#define XCD_BAR_WORDS 3456
#define XB_SPIN_CAP (1u << 18)

__device__ __forceinline__ unsigned xb_ld(unsigned* p)              { return __hip_atomic_load(p, __ATOMIC_RELAXED, __HIP_MEMORY_SCOPE_AGENT); }
__device__ __forceinline__ unsigned xb_add(unsigned* p, unsigned v) { return __hip_atomic_fetch_add(p, v, __ATOMIC_RELAXED, __HIP_MEMORY_SCOPE_AGENT); }
__device__ __forceinline__ unsigned xb_xcc_id() { return (unsigned)__builtin_amdgcn_s_getreg((3 << 11) | 20) & 0xFu; }
#define XB_SPIN(cond, bar) do { unsigned _sp = 0; while (cond) { __builtin_amdgcn_s_sleep(1); \
    if ((++_sp & 255u) == 0u) { if (xb_ld(&(bar)[XB_TMO])) break; if (_sp > XB_SPIN_CAP) { atomicAdd(&(bar)[XB_TMO], 1u); break; } } } } while (0)

struct XcdBarrier {
    unsigned* bar; unsigned x;
    volatile LAS unsigned* st;
};

__device__ __forceinline__ XcdBarrier xcd_barrier_post(unsigned* bar, volatile LAS unsigned* st) {
    XcdBarrier b; b.bar = bar; b.x = xb_xcc_id(); b.st = st;
    if (threadIdx.x == 0) (void)xb_add(&bar[XB_XCNT(b.x)], 1u);
    return b;
}
__device__ __forceinline__ void xcd_barrier_complete(unsigned* bar, unsigned x, unsigned& nloc, unsigned& nx) {
    const unsigned G = gridDim.x * gridDim.y * gridDim.z;
    unsigned sum, cnt, mine, sp = 0u;
    for (;;) {
        sum = 0u; cnt = 0u; mine = 0u;
#pragma unroll
        for (unsigned j = 0; j < 16; ++j) { const unsigned c = xb_ld(&bar[XB_XCNT(j)]); sum += c; cnt += (c > 0u) ? 1u : 0u; mine = (j == x) ? c : mine; }
        if (sum == G) break;
        __builtin_amdgcn_s_sleep(1);
        if ((++sp & 255u) == 0u) { if (xb_ld(&bar[XB_TMO])) break; if (sp > XB_SPIN_CAP) { atomicAdd(&bar[XB_TMO], 1u); break; } }
    }
    nloc = mine > 0u ? mine : 1u; nx = cnt > 0u ? cnt : 1u;
}

__device__ __forceinline__ void xcd_barrier(const XcdBarrier& b) {
    asm volatile("s_waitcnt vmcnt(0)" ::: "memory");
    __syncthreads();
    if (threadIdx.x == 0) {
        unsigned* bar = b.bar;
        __builtin_amdgcn_s_waitcnt(0);
        unsigned nloc = b.st[0], nx = b.st[1];
        if (nloc == 0u) { xcd_barrier_complete(bar, b.x, nloc, nx); b.st[0] = nloc; b.st[1] = nx; }
        const unsigned old = xb_add(&bar[XB_XSUB(b.x)], 1u);
        const unsigned gen = old / nloc;
        if (old + 1u == (gen + 1u) * nloc) {
            __builtin_amdgcn_fence(__ATOMIC_RELEASE, "agent");
            asm volatile("s_waitcnt vmcnt(0)" ::: "memory");
            const unsigned og = xb_add(&bar[XB_TOP], 1u);
            const unsigned tg = og / nx;
            if (og + 1u == (tg + 1u) * nx) xb_add(&bar[XB_TOPGEN], 1u);
            else XB_SPIN(xb_ld(&bar[XB_TOPGEN]) == tg, bar);
            __builtin_amdgcn_fence(__ATOMIC_ACQUIRE, "agent");
            xb_add(&bar[XB_XGEN(b.x)], 1u);
            asm volatile("s_waitcnt vmcnt(0)" ::: "memory");
        } else {
            XB_SPIN(xb_ld(&bar[XB_XGEN(b.x)]) == gen, bar);
            __builtin_amdgcn_fence(__ATOMIC_ACQUIRE, "agent");
            asm volatile("s_waitcnt vmcnt(0)" ::: "memory");
        }
    }
    __syncthreads();
}

constexpr int NWAVES = 8;
constexpr int D = 1024, FF = 2816, MP = 16384, MS = 512, M = MP + MS;
constexpr int PSH = 1792, PTOT = 3328, OFF_V = 1024, OFF_WD = 1536, OFF_CB = 1792, OFF_CC = 2304, OFF_CH = 2816;
constexpr int NH = 8, DR = 512;
constexpr int NGU = 2 * FF;
constexpr int NLORA = 1536, KLORA = 256;
constexpr float ALPHA = 1.189207115002721f;
constexpr float LN_EPS = 1e-5f, GN_EPS = 64e-5f;
constexpr size_t O_Y = 0, O_WKVP = (size_t)M * D, O_SHP = O_WKVP + 8 * 8 * 4096, O_CVP = O_SHP + 8 * PSH, O_WKVS = O_CVP + 8 * 2 * 512,
                 O_SHS = O_WKVS + (size_t)128 * 8 * 4096, O_CVS = O_SHS + 128 * PSH, O_END = O_CVS + 128 * 2 * 512;
constexpr size_t MiB = 1u << 20;
constexpr size_t WS_CTL = 0, CTL_ZERO_BYTES = 64 * 1024;
constexpr size_t WS_WGU1 = 1 * MiB, WS_WD1 = 12 * MiB, WS_WGU2 = 18 * MiB, WS_WD2 = 29 * MiB, WS_WIN = 35 * MiB, WS_WOUT = 42 * MiB, WS_WL = 44 * MiB;
constexpr size_t WS_XB = 45 * MiB;
constexpr size_t WS_BONUS = 78 * MiB;
constexpr size_t WS_LBIAS = 78 * MiB + 768 * 1024;
constexpr size_t WS_H = 79 * MiB;
constexpr size_t WS_PROJ = 79 * MiB;
constexpr size_t WS_AP = 187 * MiB;
constexpr size_t WS_MIX = 196 * MiB;
constexpr size_t WS_PART = 230 * MiB;
constexpr size_t WS_END = 253 * MiB;
constexpr int KSPLIT = 4;
constexpr int CW_BAR = 1024;
static_assert((CW_BAR + XCD_BAR_WORDS) * 4 <= (int)CTL_ZERO_BYTES, "ctl");
constexpr int RING_BYTES = 131072, MISC_OFF = 143360, LDS_BYTES = 147456;

__device__ __forceinline__ float bf2f(unsigned short b) { return __builtin_bit_cast(float, (unsigned)b << 16); }
__device__ __forceinline__ float bflo(unsigned w) { return __builtin_bit_cast(float, w << 16); }
__device__ __forceinline__ float bfhi(unsigned w) { return __builtin_bit_cast(float, w & 0xffff0000u); }
__device__ __forceinline__ unsigned pkbf(float lo, float hi) { return pg8::cvt_pk_bf16(lo, hi); }
__device__ __forceinline__ float wave_sum(float v) {
#pragma unroll
    for (int o = 1; o < 64; o <<= 1) v += __shfl_xor(v, o);
    return v;
}
__device__ __forceinline__ float sigmoidf_(float x) { return __builtin_amdgcn_rcpf(1.0f + __expf(-x)); }

struct Args { const float* in[31]; float* out; unsigned char* ws; };
enum { I_XP = 0, I_XS, I_SWKV, I_SSH, I_SCV, I_LN1G, I_LN1B, I_F1G, I_F1U, I_F1D, I_WIN, I_MU, I_W0, I_WLU, I_A0, I_ALU, I_GLU, I_KK, I_KA, I_RK, I_LNXG, I_LNXB, I_CW, I_WOUT,
       I_LN2G, I_LN2B, I_F2G, I_F2U, I_F2D, I_LN3G, I_LN3B };

namespace pg8 {
struct EpiSwiGLU {
    static constexpr bool PERM = true, AFTER_DRAIN = false;
    bf16_t* O; int ldc;
    __device__ __forceinline__ void operator()(const f32x4 (&acc)[2][2][4][2], const Unit& u, int wr, int wc, int fr, int fq) const {
        const int row0 = u.pm * BM + wr * 64 + fr, col0 = u.pn * 128 + wc * 32 + 8 * fq;
#pragma unroll
        for (int ai = 0; ai < 2; ++ai)
#pragma unroll
            for (int m = 0; m < 4; ++m) { bf16_t* rowp = O + (size_t)(row0 + ai * HALF + m * 16) * ldc + col0; float hv[8];
#pragma unroll
                for (int n = 0; n < 2; ++n)
#pragma unroll
                    for (int e = 0; e < 4; ++e) { const float g = acc[ai][0][m][n][e], up = acc[ai][1][m][n][e]; hv[n * 4 + e] = g * __builtin_amdgcn_rcpf(1.0f + __expf(-g)) * up; }
                u32x4 w; w.x = cvt_pk_bf16(hv[0], hv[1]); w.y = cvt_pk_bf16(hv[2], hv[3]); w.z = cvt_pk_bf16(hv[4], hv[5]); w.w = cvt_pk_bf16(hv[6], hv[7]);
                *(u32x4*)rowp = w; }
    }
};
struct EpiLoraAct {
    static constexpr bool PERM = true, AFTER_DRAIN = false;
    bf16_t* O; const float* bias;
    __device__ __forceinline__ void operator()(const f32x4 (&acc)[2][2][4][2], const Unit& u, int wr, int wc, int fr, int fq) const {
        const int row0 = u.pm * BM + wr * 64 + fr, col0 = u.pn * BM + wc * 32 + 8 * fq, ty = u.pn >> 1;
#pragma unroll
        for (int bj = 0; bj < 2; ++bj) {
            const f32x4 b0 = *(const f32x4*)(bias + col0 + bj * HALF), b1 = *(const f32x4*)(bias + col0 + bj * HALF + 4);
#pragma unroll
            for (int ai = 0; ai < 2; ++ai)
#pragma unroll
                for (int m = 0; m < 4; ++m) { f32x4 v0 = acc[ai][bj][m][0] + b0, v1 = acc[ai][bj][m][1] + b1;
                    if (ty < 2) { v0 = lora_act(v0, ty); v1 = lora_act(v1, ty); }
                    u32x4 w; w.x = cvt_pk_bf16(v0.x, v0.y); w.y = cvt_pk_bf16(v0.z, v0.w); w.z = cvt_pk_bf16(v1.x, v1.y); w.w = cvt_pk_bf16(v1.z, v1.w);
                    *(u32x4*)(O + (size_t)(row0 + ai * HALF + m * 16) * 1536 + col0 + bj * HALF) = w;
                    asm volatile("" ::: "memory"); } }
    }
};
template <bool RES_BF16> struct EpiRes {
    static constexpr bool PERM = false, AFTER_DRAIN = false;
    const void* r0; const void* r1; int split_pm; float* out; int ldc; float alpha, beta; float* part; int part_pm;
    __device__ __forceinline__ void operator()(const f32x4 (&acc)[2][2][4][2], const Unit& u, int wr, int wc, int fr, int fq) const {
        const int col0 = u.pn * BM + wc * 32 + 4 * fq;
        if (u.pm >= part_pm) { const int ks = u.k0 / u.nt;
#pragma unroll
            for (int ai = 0; ai < 2; ++ai)
#pragma unroll
                for (int m = 0; m < 4; ++m) { const size_t off = ((size_t)ks * 512 + (u.pm - part_pm) * BM + ai * HALF + wr * 64 + m * 16 + fr) * ldc + col0;
#pragma unroll
                    for (int bj = 0; bj < 2; ++bj)
#pragma unroll
                        for (int n = 0; n < 2; ++n) *(f32x4*)(part + off + bj * HALF + n * 16) = acc[ai][bj][m][n]; }
            return; }
        const char* rb = (const char*)(u.pm < split_pm ? r0 : r1); const int rrow0 = (u.pm < split_pm ? u.pm : u.pm - split_pm) * BM;
#pragma unroll
        for (int ai = 0; ai < 2; ++ai)
#pragma unroll
            for (int m = 0; m < 4; ++m) { const int rl = ai * HALF + wr * 64 + m * 16 + fr; const size_t off = (size_t)(u.pm * BM + rl) * ldc + col0; const size_t roff = (size_t)(rrow0 + rl) * ldc + col0;
#pragma unroll
                for (int bj = 0; bj < 2; ++bj)
#pragma unroll
                    for (int n = 0; n < 2; ++n) { f32x4 rv;
                        if (RES_BF16) { typedef unsigned u32x2v __attribute__((ext_vector_type(2))); const u32x2v w = *(const u32x2v*)(rb + (roff + bj * HALF + n * 16) * 2);
                            rv = (f32x4){__builtin_bit_cast(float, w.x << 16), __builtin_bit_cast(float, w.x & 0xffff0000u), __builtin_bit_cast(float, w.y << 16), __builtin_bit_cast(float, w.y & 0xffff0000u)}; }
                        else rv = *(const f32x4*)(rb + (roff + bj * HALF + n * 16) * 4);
                        *(f32x4*)(out + off + bj * HALF + n * 16) = rv * alpha + acc[ai][bj][m][n] * beta; } }
    }
};
}

struct Frame {
    LAS unsigned char* lds; int tid, lane, wave, gw, NGW, G;
};

__device__ __forceinline__ void p0_transpose_item(const float* W, int N, bf16* WT, int ldt, int coff, int drow0, LAS float* scr, int k0, int n0, int lane) {
#pragma unroll 8
    for (int i = 0; i < 32; ++i) { const int kk = 2 * i + (lane >> 5); scr[kk * 33 + (lane & 31)] = W[(size_t)(k0 + kk) * N + n0 + (lane & 31)]; }
    LDS_WAIT(); asm volatile("" ::: "memory");
    const int c = lane & 7;
#pragma unroll
    for (int j = 0; j < 4; ++j) { const int n = (lane >> 3) + 8 * j; const LAS float* s = scr + (8 * c) * 33 + n;
        v4u o; o.x = pkbf(s[0 * 33], s[1 * 33]); o.y = pkbf(s[2 * 33], s[3 * 33]); o.z = pkbf(s[4 * 33], s[5 * 33]); o.w = pkbf(s[6 * 33], s[7 * 33]);
        *(GAS v4u*)(WT + (size_t)(drow0 + n) * ldt + coff + k0 + 8 * c) = o; }
    LDS_WAIT(); asm volatile("" ::: "memory");
}

__device__ __forceinline__ void phase_prologue(const Args& A, Frame& F) {
    unsigned char* ws = A.ws;
    LAS float* scr = (LAS float*)(F.lds + F.wave * 16384);
    constexpr int I_GU = 16 * 88, I_DN = 44 * 32, I_IN = 16 * 104, I_OUT = 16 * 32, I_L64 = 16, I_L128 = 32;
    constexpr int NITEMS = 6 * I_GU + I_IN + I_OUT + 2 * I_L64 + I_L128;
    static_assert(I_GU == I_DN, "");
    for (int it = F.gw; it < NITEMS; it += F.NGW) {
        int r = it;
        if (r < 6 * I_GU) { const int mtx = r / I_GU; r -= mtx * I_GU; const int f2 = mtx >= 3, kind = mtx % 3;
            if (kind < 2) { const int nblk = FF / 32, kb = r / nblk, nb = r % nblk, n0 = nb * 32; const int drow = (n0 >> 7) * 256 + (n0 & 127) + kind * 128;
                p0_transpose_item(A.in[(f2 ? I_F2G : I_F1G) + kind], FF, (bf16*)(ws + (f2 ? WS_WGU2 : WS_WGU1)), D, 0, drow, scr, kb * 64, n0, F.lane); }
            else { const int nblk = D / 32, kb = r / nblk, nb = r % nblk;
                p0_transpose_item(A.in[f2 ? I_F2D : I_F1D], D, (bf16*)(ws + (f2 ? WS_WD2 : WS_WD1)), FF, 0, nb * 32, scr, kb * 64, nb * 32, F.lane); }
            continue; }
        r -= 6 * I_GU;
        if (r < I_IN) { const int nblk = PTOT / 32, kb = r / nblk, nb = r % nblk; p0_transpose_item(A.in[I_WIN], PTOT, (bf16*)(ws + WS_WIN), D, 0, nb * 32, scr, kb * 64, nb * 32, F.lane); continue; }
        r -= I_IN;
        if (r < I_OUT) { const int nblk = D / 32, kb = r / nblk, nb = r % nblk; p0_transpose_item(A.in[I_WOUT], D, (bf16*)(ws + WS_WOUT), D, 0, nb * 32, scr, kb * 64, nb * 32, F.lane); continue; }
        r -= I_OUT;
        if (r < I_L64) { p0_transpose_item(A.in[I_WLU], 512, (bf16*)(ws + WS_WL), KLORA, 0, r * 32, scr, 0, r * 32, F.lane); continue; }
        r -= I_L64;
        if (r < I_L64) { p0_transpose_item(A.in[I_ALU], 512, (bf16*)(ws + WS_WL), KLORA, 64, 512 + r * 32, scr, 0, r * 32, F.lane); continue; }
        r -= I_L64;
        { const int kb = r / 16, nb = r % 16; p0_transpose_item(A.in[I_GLU], 512, (bf16*)(ws + WS_WL), KLORA, 128, 1024 + nb * 32, scr, kb * 64, nb * 32, F.lane); }
    }
    { const int gt = F.gw * 64 + F.lane, NT = F.NGW * 64;
      for (int ch = gt; ch < NLORA * KLORA / 8; ch += NT) { const int row = ch >> 5, col = (ch & 31) * 8; const int ty = row >> 9;
          const bool nz = ty == 0 ? (col < 64) : (ty == 1 ? (col >= 64 && col < 128) : (col >= 128));
          if (!nz) *(GAS v4u*)((bf16*)(ws + WS_WL) + (size_t)row * KLORA + col) = (v4u){0u, 0u, 0u, 0u}; } }
    { const int gt = F.gw * 64 + F.lane; if (gt < NLORA) ((float*)(ws + WS_LBIAS))[gt] = gt < 512 ? A.in[I_W0][gt] : (gt < 1024 ? A.in[I_A0][gt - 512] : 0.f); }
    for (int m = F.gw; m < M; m += F.NGW) {
        const float* xrow = m < MP ? A.in[I_XP] + (size_t)m * D : A.in[I_XS] + (size_t)(m - MP) * D;
        const GAS f32x4* xr = (const GAS f32x4*)xrow + F.lane; GAS unsigned long long* o8 = (GAS unsigned long long*)((bf16*)(ws + WS_XB) + (size_t)m * D) + F.lane;
#pragma unroll
        for (int j = 0; j < 4; ++j) { const f32x4 v = xr[64 * j]; o8[64 * j] = (unsigned long long)pkbf(v.x, v.y) | ((unsigned long long)pkbf(v.z, v.w) << 32); }
    }
}

template <bool FINAL> __device__ __forceinline__ void phase_ln(Frame& F, float* z, bf16* xb, const float* g, const float* b, const float* part, int nsplit, const float* res_s, float alpha, float beta) {
    f32x4 gv[4], bv[4];
#pragma unroll
    for (int j = 0; j < 4; ++j) { gv[j] = ((const GAS f32x4*)g)[F.lane + 64 * j]; bv[j] = ((const GAS f32x4*)b)[F.lane + 64 * j]; }
    for (int m = F.gw; m < M; m += F.NGW) {
        GAS f32x4* xr = (GAS f32x4*)(z + (size_t)m * D) + F.lane;
        f32x4 v[4]; float s = 0.f;
        if (m >= MP) {
            const int r = m - MP; typedef unsigned u32x2v __attribute__((ext_vector_type(2)));
#pragma unroll 1
            for (int j = 0; j < 4; ++j) { f32x4 a = (f32x4){0.f, 0.f, 0.f, 0.f};
#pragma unroll 1
                for (int ks = 0; ks < nsplit; ++ks) a += *((const GAS f32x4*)(part + ((size_t)ks * 512 + r) * D) + F.lane + 64 * j);
                f32x4 rv;
                if (res_s) rv = *((const GAS f32x4*)(res_s + (size_t)r * D) + F.lane + 64 * j);
                else { const u32x2v w2 = *((const GAS u32x2v*)(xb + (size_t)m * D) + F.lane + 64 * j); rv = (f32x4){bflo(w2.x), bfhi(w2.x), bflo(w2.y), bfhi(w2.y)}; }
                xr[64 * j] = rv * alpha + a * beta; }
            asm volatile("s_waitcnt vmcnt(0)" ::: "memory");
        }
#pragma unroll
        for (int j = 0; j < 4; ++j) v[j] = xr[64 * j];
#pragma unroll
        for (int j = 0; j < 4; ++j) s += (v[j].x + v[j].y) + (v[j].z + v[j].w);
        const float mean = wave_sum(s) * (1.f / D); float s2 = 0.f;
#pragma unroll
        for (int j = 0; j < 4; ++j) { v[j] = v[j] - mean; s2 += (v[j].x * v[j].x + v[j].y * v[j].y) + (v[j].z * v[j].z + v[j].w * v[j].w); }
        const float rstd = 1.f / sqrtf(wave_sum(s2) * (1.f / D) + LN_EPS);
        if (FINAL) {
#pragma unroll
            for (int j = 0; j < 4; ++j) xr[64 * j] = v[j] * rstd * gv[j] + bv[j];
        } else {
            GAS unsigned long long* o8 = (GAS unsigned long long*)(xb + (size_t)m * D) + F.lane;
#pragma unroll
            for (int j = 0; j < 4; ++j) { const f32x4 o = v[j] * rstd * gv[j] + bv[j]; o8[64 * j] = (unsigned long long)pkbf(o.x, o.y) | ((unsigned long long)pkbf(o.z, o.w) << 32); }
        }
    }
}

struct Tok { int s, t, T; bool prompt; };
__device__ __forceinline__ Tok tok_of(int n) { Tok k; k.prompt = n < MP; if (k.prompt) { k.s = n >> 11; k.t = n & 2047; k.T = 2048; } else { const int r = n - MP; k.s = r >> 2; k.t = r & 3; k.T = 4; } return k; }

__device__ __forceinline__ void phase_prep(const Args& A, Frame& F) {
    unsigned char* ws = A.ws; const bf16* proj = (const bf16*)(ws + WS_PROJ); bf16* ap = (bf16*)(ws + WS_AP); bf16* mix = (bf16*)(ws + WS_MIX);
    const int lane = F.lane;
    const f32x4 mu4 = *(const GAS f32x4*)(A.in[I_MU] + OFF_WD + 4 * lane);
    float cw[3][8];
#pragma unroll
    for (int i = 0; i < 3; ++i)
#pragma unroll
        for (int e = 0; e < 8; ++e) cw[i][e] = A.in[I_CW][i * 512 + 8 * lane + e];
    typedef unsigned u32x2v __attribute__((ext_vector_type(2)));
    for (int n = F.gw; n < M; n += F.NGW) {
        const Tok k = tok_of(n); const bf16* pr = proj + (size_t)n * PTOT;
        { const u32x2v c = *(const GAS u32x2v*)(pr + OFF_WD + 4 * lane); f32x4 cur = (f32x4){bflo(c.x), bfhi(c.x), bflo(c.y), bfhi(c.y)}, prev;
          if (k.t > 0) { const u32x2v p = *(const GAS u32x2v*)(pr - PTOT + OFF_WD + 4 * lane); prev = (f32x4){bflo(p.x), bfhi(p.x), bflo(p.y), bfhi(p.y)}; }
          else if (!k.prompt) prev = *(const GAS f32x4*)(A.in[I_SSH] + (size_t)k.s * PSH + OFF_WD + 4 * lane);
          else prev = (f32x4){0.f, 0.f, 0.f, 0.f};
          f32x4 m = cur + mu4 * (prev - cur);
          if (lane < 16) { m.x = tanhf(m.x); m.y = tanhf(m.y); m.z = tanhf(m.z); m.w = tanhf(m.w); }
          else if (lane >= 32) { m.x = sigmoidf_(m.x); m.y = sigmoidf_(m.y); m.z = sigmoidf_(m.z); m.w = sigmoidf_(m.w); }
          u32x2v o; o.x = pkbf(m.x, m.y); o.y = pkbf(m.z, m.w); *(GAS u32x2v*)(ap + (size_t)n * KLORA + 4 * lane) = o; }
        { const v4u cbw = *(const GAS v4u*)(pr + OFF_CB + 8 * lane), ccw = *(const GAS v4u*)(pr + OFF_CC + 8 * lane), chw = *(const GAS v4u*)(pr + OFF_CH + 8 * lane);
          float u2[8], u1[8], u0[8], cb[8];
#pragma unroll
          for (int e = 0; e < 4; ++e) { u2[2 * e] = bflo(ccw[e]) * bflo(chw[e]); u2[2 * e + 1] = bfhi(ccw[e]) * bfhi(chw[e]); cb[2 * e] = bflo(cbw[e]); cb[2 * e + 1] = bfhi(cbw[e]); }
          const float* sc = A.in[I_SCV] + (size_t)k.s * 1024 + 8 * lane;
          if (k.t >= 1) { const v4u a = *(const GAS v4u*)(pr - PTOT + OFF_CC + 8 * lane), b = *(const GAS v4u*)(pr - PTOT + OFF_CH + 8 * lane);
#pragma unroll
              for (int e = 0; e < 4; ++e) { u1[2 * e] = bflo(a[e]) * bflo(b[e]); u1[2 * e + 1] = bfhi(a[e]) * bfhi(b[e]); } }
          else {
#pragma unroll
              for (int e = 0; e < 8; ++e) u1[e] = k.prompt ? 0.f : sc[512 + e]; }
          if (k.t >= 2) { const v4u a = *(const GAS v4u*)(pr - 2 * PTOT + OFF_CC + 8 * lane), b = *(const GAS v4u*)(pr - 2 * PTOT + OFF_CH + 8 * lane);
#pragma unroll
              for (int e = 0; e < 4; ++e) { u0[2 * e] = bflo(a[e]) * bflo(b[e]); u0[2 * e + 1] = bfhi(a[e]) * bfhi(b[e]); } }
          else {
#pragma unroll
              for (int e = 0; e < 8; ++e) u0[e] = k.prompt ? 0.f : sc[k.t * 512 + e]; }
          float y[8];
#pragma unroll
          for (int e = 0; e < 8; ++e) y[e] = cb[e] * (cw[0][e] * u0[e] + cw[1][e] * u1[e] + cw[2][e] * u2[e]);
          v4u o; o.x = pkbf(y[0], y[1]); o.y = pkbf(y[2], y[3]); o.z = pkbf(y[4], y[5]); o.w = pkbf(y[6], y[7]);
          *(GAS v4u*)(mix + (size_t)n * D + 512 + 8 * lane) = o;
          if (k.t >= k.T - 2) { float* co = A.out + (k.prompt ? O_CVP : O_CVS) + ((size_t)k.s * 2 + (k.t - (k.T - 2))) * 512 + 8 * lane;
              *(GAS f32x4*)co = (f32x4){u2[0], u2[1], u2[2], u2[3]}; *(GAS f32x4*)(co + 4) = (f32x4){u2[4], u2[5], u2[6], u2[7]}; } }
        if (k.t == k.T - 1) { float* so = A.out + (k.prompt ? O_SHP : O_SHS) + (size_t)k.s * PSH;
#pragma unroll
            for (int i = 0; i < 7; ++i) { const u32x2v c = *(const GAS u32x2v*)(pr + 256 * i + 4 * lane); *(GAS f32x4*)(so + 256 * i + 4 * lane) = (f32x4){bflo(c.x), bfhi(c.x), bflo(c.y), bfhi(c.y)}; } }
    }
}

constexpr int TC = 32, RB_TOK = 320, RB_VT = TC * RB_TOK, VT_LD = 36, RB_FLOATS = RB_VT + 64 * VT_LD;
constexpr int REC_OBUF_OFF = 2 * RB_FLOATS * 4;
constexpr int OB_LD = 68;
static_assert(REC_OBUF_OFF + 4 * TC * OB_LD * 4 <= MISC_OFF - 320, "recurrence LDS");
__device__ __forceinline__ float row16_allsum(float x) {
    x += __builtin_bit_cast(float, __builtin_amdgcn_update_dpp(0, __builtin_bit_cast(int, x), 0x128, 0xf, 0xf, false));
    x += __builtin_bit_cast(float, __builtin_amdgcn_update_dpp(0, __builtin_bit_cast(int, x), 0x124, 0xf, 0xf, false));
    x += __builtin_bit_cast(float, __builtin_amdgcn_update_dpp(0, __builtin_bit_cast(int, x), 0x122, 0xf, 0xf, false));
    x += __builtin_bit_cast(float, __builtin_amdgcn_update_dpp(0, __builtin_bit_cast(int, x), 0x121, 0xf, 0xf, false));
    return x;
}
struct RecItem { int n0, ntok, s, h, q; bool prompt; };
__device__ __forceinline__ RecItem rec_item(int b, int i) {
    RecItem it;
    if (i < 64) { it.prompt = true; it.s = b >> 5; it.h = (b >> 2) & 7; it.q = b & 3; it.n0 = it.s * 2048 + TC * i; it.ntok = TC; }
    else { const int su = b * 4 + (i - 64); it.prompt = false; it.s = su >> 3; it.h = su & 7; it.q = 0; it.n0 = MP + it.s * 4; it.ntok = 4; }
    return it;
}
struct RecPar { float mur, muk, muv, kkp, kap, rkp, w0p, a0p; };
struct RecRaw { unsigned short rr[9], kr[9], vr[9], ar[8], wr[8]; float fp[3]; RecPar P; };
__device__ __forceinline__ void rec_emit(const RecPar& P, float r, float k, float v, float araw, float wraw, LAS float* buf, int tt, int lane, float* bonus_out) {
    const float a = araw, w = 1.0f - wraw;
    const float kkr = k * P.kkp; const float ss2 = wave_sum(kkr * kkr); const float kk = kkr * fminf(__builtin_amdgcn_rsqf(ss2), 1e12f);
    const float k2 = k * (1.0f + (a - 1.0f) * P.kap), nb = -kk * a;
    const float bon = wave_sum(r * k2 * P.rkp);
    if (bonus_out && lane == 0) *bonus_out = bon;
    LAS float* bt = buf + tt * RB_TOK;
    bt[lane] = r; bt[64 + lane] = w; bt[128 + lane] = k2; bt[192 + lane] = kk; bt[256 + lane] = nb; buf[RB_VT + lane * VT_LD + tt] = v;
}
__device__ __forceinline__ void rec_load_raw(const Args& A, const RecItem& it, int pw, int lane, RecRaw& R) {
    const bf16* proj = (const bf16*)(A.ws + WS_PROJ); const bf16* lora = (const bf16*)A.out;
    const int c = it.h * 64 + lane;
    R.P.mur = A.in[I_MU][c]; R.P.muk = A.in[I_MU][512 + c]; R.P.muv = A.in[I_MU][1024 + c]; R.P.kkp = A.in[I_KK][c]; R.P.kap = A.in[I_KA][c]; R.P.rkp = A.in[I_RK][c]; R.P.w0p = A.in[I_W0][c]; R.P.a0p = A.in[I_A0][c];
    if (it.prompt) {
        const int n1 = it.n0 + pw * 8; const bool has_prev = (n1 & 2047) != 0;
        const bf16* pr = proj + (size_t)n1 * PTOT + c; const bf16* lr = lora + (size_t)n1 * NLORA + c;
        R.rr[0] = 0; R.kr[0] = 0; R.vr[0] = 0;
        if (has_prev) { R.rr[0] = pr[-PTOT]; R.kr[0] = pr[512 - PTOT]; R.vr[0] = pr[1024 - PTOT]; }
#pragma unroll
        for (int i = 0; i < 8; ++i) { R.rr[i + 1] = pr[(size_t)i * PTOT]; R.kr[i + 1] = pr[(size_t)i * PTOT + 512]; R.vr[i + 1] = pr[(size_t)i * PTOT + 1024]; R.wr[i] = lr[(size_t)i * NLORA]; R.ar[i] = lr[(size_t)i * NLORA + 512]; }
    } else {
        const int tt = pw, n = it.n0 + tt; const bf16* pr = proj + (size_t)n * PTOT + c;
        R.rr[1] = pr[0]; R.kr[1] = pr[512]; R.vr[1] = pr[1024]; R.ar[0] = lora[(size_t)n * NLORA + 512 + c]; R.wr[0] = lora[(size_t)n * NLORA + c];
        if (tt > 0) { R.fp[0] = bf2f(pr[-PTOT]); R.fp[1] = bf2f(pr[512 - PTOT]); R.fp[2] = bf2f(pr[1024 - PTOT]); }
        else { const float* ss = A.in[I_SSH] + (size_t)it.s * PSH + c; R.fp[0] = ss[0]; R.fp[1] = ss[512]; R.fp[2] = ss[1024]; }
    }
}
__device__ __forceinline__ void rec_compute(const Args& A, const RecItem& it, bool has_nx, const RecItem& nx, int pw, int lane, RecRaw& R, LAS float* buf) {
    float* bonus = (float*)(A.ws + WS_BONUS); const RecPar P = R.P;
    if (it.prompt) {
        const int n1 = it.n0 + pw * 8; const bool inter = has_nx && nx.prompt;
        const int m1 = nx.n0 + pw * 8; const bool nx_prev = (m1 & 2047) != 0;
        const bf16* pr = (const bf16*)(A.ws + WS_PROJ) + (size_t)m1 * PTOT + it.h * 64 + lane; const bf16* lr = (const bf16*)A.out + (size_t)m1 * NLORA + it.h * 64 + lane;
        LAS float* b0 = buf + (pw * 8) * RB_TOK;
        float vr_[8], vw_[8], vk2[8], vkkr[8], va[8], vv[8];
#pragma unroll
        for (int i = 0; i < 8; ++i) {
            const float rc = bf2f(R.rr[i + 1]), kc = bf2f(R.kr[i + 1]), vc = bf2f(R.vr[i + 1]), rp = bf2f(R.rr[i]), kp = bf2f(R.kr[i]), vp = bf2f(R.vr[i]);
            const float ai = bf2f(R.ar[i]), wi = bf2f(R.wr[i]);
            if (inter) {
                if (i > 0 || nx_prev) { R.rr[i] = pr[(ptrdiff_t)(i - 1) * PTOT]; R.kr[i] = pr[(ptrdiff_t)(i - 1) * PTOT + 512]; R.vr[i] = pr[(ptrdiff_t)(i - 1) * PTOT + 1024]; } else { R.rr[0] = 0; R.kr[0] = 0; R.vr[0] = 0; }
                R.wr[i] = lr[(size_t)i * NLORA]; R.ar[i] = lr[(size_t)i * NLORA + 512];
                if (i == 7) { R.rr[8] = pr[(size_t)7 * PTOT]; R.kr[8] = pr[(size_t)7 * PTOT + 512]; R.vr[8] = pr[(size_t)7 * PTOT + 1024]; } }
            const float r = rc + P.mur * (rp - rc), k = kc + P.muk * (kp - kc); vv[i] = vc + P.muv * (vp - vc);
            const float a = ai; vw_[i] = 1.0f - wi;
            const float kkr = k * P.kkp, k2 = k * (1.0f + (a - 1.0f) * P.kap);
            vr_[i] = r; vk2[i] = k2; vkkr[i] = kkr; va[i] = a;
            b0[i * RB_TOK + lane] = kkr * kkr; b0[i * RB_TOK + 64 + lane] = r * k2 * P.rkp;
        }
        { const int sidx = lane >> 2, tok = sidx & 7, which = sidx >> 3, part = lane & 3;
          const LAS f32x4* p = (const LAS f32x4*)(b0 + tok * RB_TOK + which * 64 + part * 16);
          const f32x4 s4 = (p[0] + p[1]) + (p[2] + p[3]); float s = (s4.x + s4.y) + (s4.z + s4.w);
          s += __builtin_bit_cast(float, __builtin_amdgcn_update_dpp(0, __builtin_bit_cast(int, s), 0xB1, 0xf, 0xf, false));
          s += __builtin_bit_cast(float, __builtin_amdgcn_update_dpp(0, __builtin_bit_cast(int, s), 0x4E, 0xf, 0xf, false));
          const float rn = fminf(__builtin_amdgcn_rsqf(s), 1e12f);
          if (part == 0) { if (which == 0) b0[128 + tok] = rn; else if (it.q == 0) bonus[(size_t)(n1 + tok) * 8 + it.h] = s; } }
        const f32x4 rn0 = *(const LAS f32x4*)(b0 + 128), rn1 = *(const LAS f32x4*)(b0 + 132);
#pragma unroll
        for (int i = 0; i < 8; ++i) { const float rn = i < 4 ? rn0[i & 3] : rn1[i & 3]; const float kk = vkkr[i] * rn; LAS float* bt = b0 + i * RB_TOK;
            bt[lane] = vr_[i]; bt[64 + lane] = vw_[i]; bt[128 + lane] = vk2[i]; bt[192 + lane] = kk; bt[256 + lane] = -kk * va[i]; buf[RB_VT + lane * VT_LD + pw * 8 + i] = vv[i]; }
        if (has_nx && !inter) rec_load_raw(A, nx, pw, lane, R);
    } else {
        const int tt = pw, n = it.n0 + tt; const float rc = bf2f(R.rr[1]), kc = bf2f(R.kr[1]), vc = bf2f(R.vr[1]);
        const float f0 = R.fp[0], f1 = R.fp[1], f2 = R.fp[2], ai = bf2f(R.ar[0]), wi = bf2f(R.wr[0]);
        if (has_nx) rec_load_raw(A, nx, pw, lane, R);
        rec_emit(P, rc + P.mur * (f0 - rc), kc + P.muk * (f1 - kc), vc + P.muv * (f2 - vc), ai, wi, buf, tt, lane, bonus + (size_t)n * 8 + it.h);
    }
}
typedef float f32x2 __attribute__((ext_vector_type(2)));
struct RV { f32x4 kk, w, nb, k, r; };
__device__ __forceinline__ void rec_load(RV& X, const LAS float* bt, int l) {
    X.kk = *(const LAS f32x4*)(bt + 192 + 4 * l); X.w = *(const LAS f32x4*)(bt + 64 + 4 * l); X.nb = *(const LAS f32x4*)(bt + 256 + 4 * l);
    X.k = *(const LAS f32x4*)(bt + 128 + 4 * l); X.r = *(const LAS f32x4*)(bt + 4 * l);
}
__device__ __forceinline__ float rec_comp(f32x4& S, const RV& X, float vi) {
    f32x2 p = S.xy * X.kk.xy; p = S.zw * X.kk.zw + p; float d_ = row16_allsum(p.x + p.y);
    const f32x4 T_ = S * X.w + X.k * vi; S = T_ + X.nb * d_;
    f32x2 q = S.xy * X.r.xy; q = S.zw * X.r.zw + q; return q.x + q.y;
}
#define REC_BAR() do { asm volatile("s_waitcnt lgkmcnt(0)" ::: "memory"); __builtin_amdgcn_s_barrier(); asm volatile("" ::: "memory"); } while (0)
__device__ __forceinline__ void phase_recurrence(const Args& A, Frame& F) {
    LAS float* bufs = (LAS float*)F.lds;
    LAS float* obuf = (LAS float*)(F.lds + REC_OBUF_OFF) + (F.wave & 3) * (TC * OB_LD);
    bf16* mix = (bf16*)(A.ws + WS_MIX);
    const int b = blockIdx.x, lane = F.lane, w = F.wave, l = lane & 15, rg = lane >> 4;
    constexpr int NIT = 68;
    f32x4 S = (f32x4){0.f, 0.f, 0.f, 0.f};
    RecRaw R;
    if (w >= 4) { rec_load_raw(A, rec_item(b, 0), w - 4, lane, R); rec_compute(A, rec_item(b, 0), true, rec_item(b, 1), w - 4, lane, R, bufs); }
    REC_BAR();
    for (int i = 0; i < NIT; ++i) {
        if (w >= 4) {
            if (i + 1 < NIT) rec_compute(A, rec_item(b, i + 1), i + 2 < NIT, rec_item(b, i + 2 < NIT ? i + 2 : i + 1), w - 4, lane, R, bufs + ((i + 1) & 1) * RB_FLOATS);
        } else {
            __builtin_amdgcn_s_setprio(2);
            const RecItem it = rec_item(b, i); const LAS float* buf = bufs + (i & 1) * RB_FLOATS;
            if (it.prompt) {
                const int irow = it.q * 16 + w * 4 + rg; const LAS float* vrow = buf + RB_VT + irow * VT_LD; float opv[TC];
f32x4 v4[TC / 4];
#pragma unroll
                for (int t4 = 0; t4 < TC / 4; ++t4) v4[t4] = *(const LAS f32x4*)(vrow + 4 * t4);
                RV X[4]; rec_load(X[0], buf, l); rec_load(X[1], buf + RB_TOK, l); rec_load(X[2], buf + 2 * RB_TOK, l);
#pragma unroll
                for (int t = 0; t < TC; ++t) {
                    if (t + 3 < TC) rec_load(X[(t + 3) & 3], buf + (t + 3) * RB_TOK, l);
                    __builtin_amdgcn_sched_barrier(0);
                    opv[t] = rec_comp(S, X[t & 3], v4[t >> 2][t & 3]);
                    __builtin_amdgcn_sched_barrier(0);
                }
#pragma unroll
                for (int t = 0; t < TC; ++t) obuf[t * OB_LD + lane] = opv[t];
                { const int t = lane >> 1, pr2 = lane & 1; const LAS f32x4* p0 = (const LAS f32x4*)(obuf + t * OB_LD + pr2 * 32);
                  const f32x4 a0 = p0[0], a1 = p0[1], a2 = p0[2], a3 = p0[3], b0 = p0[4], b1 = p0[5], b2 = p0[6], b3 = p0[7];
                  const f32x4 sa = (a0 + a1) + (a2 + a3), sb = (b0 + b1) + (b2 + b3);
                  const float o0 = (sa.x + sa.y) + (sa.z + sa.w), o1 = (sb.x + sb.y) + (sb.z + sb.w);
                  *(GAS unsigned*)(mix + (size_t)(it.n0 + t) * D + it.h * 64 + it.q * 16 + w * 4 + 2 * pr2) = pkbf(o0, o1); }
                if (i == 63) *(GAS f32x4*)(A.out + O_WKVP + ((size_t)(it.s * 8 + it.h) * 64 + irow) * 64 + 4 * l) = S;
            } else {
                f32x4 Sq[4]; float ops[16];
#pragma unroll
                for (int qq = 0; qq < 4; ++qq) Sq[qq] = *(const GAS f32x4*)(A.in[I_SWKV] + ((size_t)(it.s * 8 + it.h) * 64 + qq * 16 + w * 4 + rg) * 64 + 4 * l);
#pragma unroll
                for (int qq = 0; qq < 4; ++qq) { const int irow = qq * 16 + w * 4 + rg; const f32x4 v4 = *(const LAS f32x4*)(buf + RB_VT + irow * VT_LD);
#pragma unroll
                    for (int t = 0; t < 4; ++t) { RV X; rec_load(X, buf + t * RB_TOK, l); ops[t * 4 + qq] = rec_comp(Sq[qq], X, v4[t]); }
                    *(GAS f32x4*)(A.out + O_WKVS + ((size_t)(it.s * 8 + it.h) * 64 + irow) * 64 + 4 * l) = Sq[qq]; }
#pragma unroll
                for (int x = 0; x < 16; ++x) obuf[x * OB_LD + lane] = ops[x];
                { const int t = lane >> 4, qq = (lane >> 2) & 3, rr = lane & 3; const LAS f32x4* p0 = (const LAS f32x4*)(obuf + (t * 4 + qq) * OB_LD + rr * 16);
                  const f32x4 sa = (p0[0] + p0[1]) + (p0[2] + p0[3]); const float o = (sa.x + sa.y) + (sa.z + sa.w);
                  mix[(size_t)(it.n0 + t) * D + it.h * 64 + qq * 16 + w * 4 + rr] = (bf16)(pkbf(o, 0.f) & 0xffffu); }
            }
            __builtin_amdgcn_s_setprio(0);
        }
        REC_BAR();
    }
}

__device__ __forceinline__ void phase_post(const Args& A, Frame& F) {
    unsigned char* ws = A.ws; const bf16* proj = (const bf16*)(ws + WS_PROJ); bf16* mix = (bf16*)(ws + WS_MIX);
    const bf16* recg = (const bf16*)A.out + 1024;   const float* bonus = (const float*)(ws + WS_BONUS);
    const int lane = F.lane, c0 = 8 * lane, h = lane >> 3;
    float muv[8], lg[8], lb[8];
#pragma unroll
    for (int e = 0; e < 8; ++e) { muv[e] = A.in[I_MU][OFF_V + c0 + e]; lg[e] = A.in[I_LNXG][c0 + e]; lb[e] = A.in[I_LNXB][c0 + e]; }
    for (int n = F.gw; n < M; n += F.NGW) {
        const Tok k = tok_of(n);
        const v4u ow = *(const GAS v4u*)(mix + (size_t)n * D + c0), gw4 = *(const GAS v4u*)(recg + (size_t)n * NLORA + c0), vcw = *(const GAS v4u*)(proj + (size_t)n * PTOT + OFF_V + c0);
        float o[8], g[8], v[8], vp[8];
#pragma unroll
        for (int e = 0; e < 4; ++e) { o[2 * e] = bflo(ow[e]); o[2 * e + 1] = bfhi(ow[e]); g[2 * e] = bflo(gw4[e]); g[2 * e + 1] = bfhi(gw4[e]); v[2 * e] = bflo(vcw[e]); v[2 * e + 1] = bfhi(vcw[e]); }
        if (k.t > 0) { const v4u pw4 = *(const GAS v4u*)(proj + (size_t)(n - 1) * PTOT + OFF_V + c0);
#pragma unroll
            for (int e = 0; e < 4; ++e) { vp[2 * e] = bflo(pw4[e]); vp[2 * e + 1] = bfhi(pw4[e]); } }
        else {
#pragma unroll
            for (int e = 0; e < 8; ++e) vp[e] = k.prompt ? 0.f : A.in[I_SSH][(size_t)k.s * PSH + OFF_V + c0 + e]; }
        float s = 0.f;
#pragma unroll
        for (int e = 0; e < 8; ++e) s += o[e];
        s += __shfl_xor(s, 1); s += __shfl_xor(s, 2); s += __shfl_xor(s, 4);
        const float mean = s * (1.f / 64.f); float q = 0.f;
#pragma unroll
        for (int e = 0; e < 8; ++e) { o[e] -= mean; q += o[e] * o[e]; }
        q += __shfl_xor(q, 1); q += __shfl_xor(q, 2); q += __shfl_xor(q, 4);
        const float rstd = 1.0f / sqrtf(q * (1.f / 64.f) + GN_EPS); const float bon = bonus[(size_t)n * 8 + h];
        float y[8];
#pragma unroll
        for (int e = 0; e < 8; ++e) { const float vm = v[e] + muv[e] * (vp[e] - v[e]); y[e] = (o[e] * rstd * lg[e] + lb[e] + bon * vm) * g[e]; }
        v4u ov; ov.x = pkbf(y[0], y[1]); ov.y = pkbf(y[2], y[3]); ov.z = pkbf(y[4], y[5]); ov.w = pkbf(y[6], y[7]);
        *(GAS v4u*)(mix + (size_t)n * D + c0) = ov;
    }
}

__global__ void __launch_bounds__(NWAVES * 64, 2) mk_fwd(Args A) {
    extern __shared__ __attribute__((aligned(16))) unsigned char lds_raw[];
    Frame F; F.lds = (LAS unsigned char*)lds_raw; F.tid = threadIdx.x; F.lane = F.tid & 63; F.wave = __builtin_amdgcn_readfirstlane(F.tid >> 6);
    F.G = gridDim.x; F.gw = blockIdx.x * NWAVES + F.wave; F.NGW = F.G * NWAVES;
    volatile LAS unsigned* MISC = (volatile LAS unsigned*)(F.lds + MISC_OFF);
    for (int u = F.tid; u < (LDS_BYTES - MISC_OFF) / 4; u += NWAVES * 64) ((LAS unsigned*)(F.lds + MISC_OFF))[u] = 0u;
    __syncthreads();
    unsigned char* ws = A.ws;
    XcdBarrier bar = xcd_barrier_post((unsigned*)(ws + WS_CTL) + CW_BAR, MISC + 8);
#define GRID_BAR() xcd_barrier(bar)
    bf16* XB = (bf16*)(ws + WS_XB); bf16* HB = (bf16*)(ws + WS_H); bf16* PROJ = (bf16*)(ws + WS_PROJ); bf16* AP = (bf16*)(ws + WS_AP); bf16* MIX = (bf16*)(ws + WS_MIX);
    float* Z = A.out + O_Y; float* PART = (float*)(ws + WS_PART);
    LAS unsigned char* ring = F.lds;

#ifndef PHMASK
#define PHMASK 0xFFFF
#endif
#if (PHMASK >> 0) & 1
    phase_prologue(A, F); GRID_BAR();
#endif
#if (PHMASK >> 1) & 1
    { pg8::Gemm g{XB, (const bf16*)(ws + WS_WGU1), M, NGU, D}; pg8::StaticOrder S; S.init(M, NGU, F.G, (int)blockIdx.x, D); pg8::EpiSwiGLU E{HB, FF};
      pg8::gemm_phase<pg8::EpiSwiGLU, pg8::StaticOrder, true, true>(ring, g, S, E); }
#endif
    GRID_BAR();
#if (PHMASK >> 2) & 1
    { pg8::Gemm g{HB, (const bf16*)(ws + WS_WD1), M, D, FF}; pg8::SplitOrder S; S.init(MP, D, F.G, (int)blockIdx.x, FF, KSPLIT); pg8::EpiRes<false> E{A.in[I_XP], A.in[I_XS], MP / 256, Z, D, ALPHA, 0.5f, PART, MP / 256};
      pg8::gemm_phase<pg8::EpiRes<false>, pg8::SplitOrder, true, true>(ring, g, S, E); }
#endif
    GRID_BAR();
#if (PHMASK >> 3) & 1
    phase_ln<false>(F, Z, XB, A.in[I_LN1G], A.in[I_LN1B], PART, (FF / 64) / KSPLIT, A.in[I_XS], ALPHA, 0.5f); GRID_BAR();
#endif
#if (PHMASK >> 4) & 1
    { pg8::Gemm g{XB, (const bf16*)(ws + WS_WIN), M, PTOT, D}; pg8::StaticOrder S; S.init(M, PTOT, F.G, (int)blockIdx.x, D); pg8::EpiBf16<0> E{PROJ, PTOT, nullptr, 0, 0, 1.f};
      pg8::gemm_phase<pg8::EpiBf16<0>, pg8::StaticOrder, true, true>(ring, g, S, E); }
#endif
    GRID_BAR();
#if (PHMASK >> 5) & 1
    phase_prep(A, F); GRID_BAR();
#endif
#if (PHMASK >> 6) & 1
    { int klora = KLORA; asm volatile("" : "+s"(klora));
      pg8::Gemm g{AP, (const bf16*)(ws + WS_WL), M, NLORA, klora}; pg8::StaticOrder S; S.init(M, NLORA, F.G, (int)blockIdx.x, KLORA);
      pg8::EpiLoraAct E{(bf16*)A.out, (const float*)(ws + WS_LBIAS)};
      pg8::gemm_phase<pg8::EpiLoraAct, pg8::StaticOrder, true, true>(ring, g, S, E); }
#endif
    GRID_BAR();
#if (PHMASK >> 7) & 1
    phase_recurrence(A, F); GRID_BAR();
#endif
#if (PHMASK >> 8) & 1
    phase_post(A, F); GRID_BAR();
#endif
#if (PHMASK >> 9) & 1
    { pg8::Gemm g{MIX, (const bf16*)(ws + WS_WOUT), M, D, D}; pg8::SplitOrder S; S.init(MP, D, F.G, (int)blockIdx.x, D, KSPLIT); pg8::EpiRes<true> E{XB, XB, 1 << 30, Z, D, ALPHA, 1.0f, PART, MP / 256};
      pg8::gemm_phase<pg8::EpiRes<true>, pg8::SplitOrder, true, true>(ring, g, S, E); }
#endif
    GRID_BAR();
#if (PHMASK >> 10) & 1
    phase_ln<false>(F, Z, XB, A.in[I_LN2G], A.in[I_LN2B], PART, (D / 64) / KSPLIT, nullptr, ALPHA, 1.0f); GRID_BAR();
#endif
#if (PHMASK >> 11) & 1
    { pg8::Gemm g{XB, (const bf16*)(ws + WS_WGU2), M, NGU, D}; pg8::StaticOrder S; S.init(M, NGU, F.G, (int)blockIdx.x, D); pg8::EpiSwiGLU E{HB, FF};
      pg8::gemm_phase<pg8::EpiSwiGLU, pg8::StaticOrder, true, true>(ring, g, S, E); }
#endif
    GRID_BAR();
#if (PHMASK >> 12) & 1
    { pg8::Gemm g{HB, (const bf16*)(ws + WS_WD2), M, D, FF}; pg8::SplitOrder S; S.init(MP, D, F.G, (int)blockIdx.x, FF, KSPLIT); pg8::EpiRes<true> E{XB, XB, 1 << 30, Z, D, ALPHA, 0.5f, PART, MP / 256};
      pg8::gemm_phase<pg8::EpiRes<true>, pg8::SplitOrder, true, true>(ring, g, S, E); }
#endif
    GRID_BAR();
#if (PHMASK >> 13) & 1
    phase_ln<true>(F, Z, XB, A.in[I_LN3G], A.in[I_LN3B], PART, (FF / 64) / KSPLIT, nullptr, ALPHA, 0.5f);
#endif
}

extern "C" void kernel_launch(void* const* d_in, const int* in_sizes, int n_in, void* d_out, int out_size, void* d_ws, size_t ws_size, hipStream_t stream) {
    static int grid = 0;
    if (grid == 0) {
        if (n_in != 31 || out_size != (int)O_END || ws_size < WS_END) { fprintf(stderr, "kernel_launch: unexpected sizes n_in %d out %d ws %zu\n", n_in, out_size, ws_size); grid = -1; return; }
        int dev = 0, cus = 0, per_cu = 0;
        if (hipGetDevice(&dev) != hipSuccess || hipDeviceGetAttribute(&cus, hipDeviceAttributeMultiprocessorCount, dev) != hipSuccess) { grid = -1; return; }
        if (hipFuncSetAttribute((const void*)mk_fwd, hipFuncAttributeMaxDynamicSharedMemorySize, LDS_BYTES) != hipSuccess) { fprintf(stderr, "kernel_launch: hipFuncSetAttribute failed\n"); grid = -1; return; }
        if (hipOccupancyMaxActiveBlocksPerMultiprocessor(&per_cu, (const void*)mk_fwd, NWAVES * 64, LDS_BYTES) != hipSuccess || per_cu < 1) { fprintf(stderr, "kernel_launch: occupancy query says %d\n", per_cu); (void)hipGetLastError(); grid = -1; return; }
        if (cus != 256) { fprintf(stderr, "kernel_launch: built for 256 CUs, found %d\n", cus); grid = -1; return; }
        grid = 256;
    }
    if (grid < 0) return;
    (void)hipMemsetAsync((char*)d_ws + WS_CTL, 0, CTL_ZERO_BYTES, stream);
    Args a{};
    for (int i = 0; i < 31; ++i) a.in[i] = (const float*)d_in[i];
    a.out = (float*)d_out; a.ws = (unsigned char*)d_ws;
    hipLaunchKernelGGL(mk_fwd, dim3(grid), dim3(NWAVES * 64), LDS_BYTES, stream, a);
}
```
